# Optimizing an MI355X kernel written in HIP

```python
import math
import jax, jax.numpy as jnp
from jax import lax
import numpy as np

D_MODEL = 2048
BATCH = 1
SEQ = 8192
DEPTH = 4
DEC_BATCH = 8
DEC_SEQ = 4096
PAST_LEN = 128

N_MIXERS = 3
N_A_LAYERS = (DEPTH + 2) // 3
N_B_LAYERS = (DEPTH + 1) // 3
N_C_LAYERS = DEPTH // 3
N_MEM = 256
D_FF = 5504
CHUNK = 128
A_WIDTH = D_MODEL
A_GROUPS = 8
A_GROUP_DIM = A_WIDTH // A_GROUPS
B_HEADS = 8
B_HEAD_DIM = D_MODEL // (2 * B_HEADS)
B_VALUE_DIM = 2 * B_HEAD_DIM
ROT_DIM = B_HEAD_DIM // 4
ROPE_THETA = 500000.0
Q_BLOCK = 128
C_GROUPS = 8
C_GROUP_DIM = D_MODEL // C_GROUPS
X_HEADS = 4
X_HEAD_DIM = 128
X_WIDTH = X_HEADS * X_HEAD_DIM
NORM_EPS = 1e-6
SUBLN_EPS = 1e-5
LN_EPS = 1e-5

kernel_name = "hybrid_bidir_gmlp_diffattn_fnet_encoder"

F32 = jnp.float32


def rmsnorm(x, g, eps=NORM_EPS):
    xf = x.astype(F32)
    y = xf * lax.rsqrt(jnp.mean(xf * xf, axis=-1, keepdims=True) + eps)
    return (y * g.astype(F32)).astype(x.dtype)


def layernorm(x, g, b, eps=LN_EPS):
    xf = x.astype(F32)
    mu = jnp.mean(xf, axis=-1, keepdims=True)
    xc = xf - mu
    var = jnp.mean(xc * xc, axis=-1, keepdims=True)
    return (xc * lax.rsqrt(var + eps) * g.astype(F32) + b.astype(F32)).astype(x.dtype)


def swiglu(x, w_gate, w_up, w_down):
    return (jax.nn.silu(x @ w_gate) * (x @ w_up)) @ w_down


def chunked_gmlp(xn, w_in, ln_g, ln_b, w_s, b_s, w_out):
    b, s, _ = xn.shape
    h = jax.nn.gelu(xn @ w_in, approximate=False)
    u, v = jnp.split(h, 2, axis=-1)
    v = layernorm(v, ln_g, ln_b)
    v = v.reshape(b, s // CHUNK, CHUNK, A_GROUPS, A_GROUP_DIM)
    mixed = jnp.einsum('gpq,bcqgd->bcpgd', w_s, v) + b_s.T[:, :, None]
    return (u * mixed.reshape(b, s, A_WIDTH)) @ w_out


def rotary_tables(s):
    inv_freq = 1.0 / (ROPE_THETA ** (jnp.arange(0, ROT_DIM, 2, dtype=F32) / ROT_DIM))
    ang = jnp.arange(s, dtype=F32)[:, None] * inv_freq[None, :]
    return jnp.cos(ang), jnp.sin(ang)


def partial_rotary(x, cos, sin):
    xf = x.astype(F32)
    half = ROT_DIM // 2
    x1 = xf[..., :half]
    x2 = xf[..., half:ROT_DIM]
    c = cos[None, :, None, None, :]
    sn = sin[None, :, None, None, :]
    out = jnp.concatenate([x1 * c - x2 * sn, x2 * c + x1 * sn, xf[..., ROT_DIM:]], axis=-1)
    return out.astype(x.dtype)


def diff_attention(xn, w_qkv, lam_q1, lam_k1, lam_q2, lam_k2, subln_g, w_out, layer_idx):
    b, s, _ = xn.shape
    q, k, v = jnp.split(xn @ w_qkv, 3, axis=-1)
    q = q.reshape(b, s, B_HEADS, 2, B_HEAD_DIM)
    k = k.reshape(b, s, B_HEADS, 2, B_HEAD_DIM)
    v = v.reshape(b, s, B_HEADS, B_VALUE_DIM)
    cos, sin = rotary_tables(s)
    q = partial_rotary(q, cos, sin) * (B_HEAD_DIM ** -0.5)
    k = partial_rotary(k, cos, sin)
    lam_init = 0.8 - 0.6 * math.exp(-0.3 * layer_idx)
    lam = (jnp.exp(jnp.sum(lam_q1.astype(F32) * lam_k1.astype(F32)))
           - jnp.exp(jnp.sum(lam_q2.astype(F32) * lam_k2.astype(F32))) + lam_init)
    q_blocks = jnp.moveaxis(q.reshape(b, s // Q_BLOCK, Q_BLOCK, B_HEADS, 2, B_HEAD_DIM), 1, 0)

    def attend(qb):
        scores = jnp.einsum('bqhcd,bkhcd->bhcqk', qb, k, preferred_element_type=F32)
        p = jax.nn.softmax(scores, axis=-1)
        diff = (p[:, :, 0] - lam * p[:, :, 1]).astype(v.dtype)
        return jnp.einsum('bhqk,bkhe->bqhe', diff, v)

    o = lax.map(attend, q_blocks)
    o = jnp.moveaxis(o, 0, 1).reshape(b, s, B_HEADS, B_VALUE_DIM)
    o = rmsnorm(o, subln_g, eps=SUBLN_EPS) * (1.0 - lam_init)
    return o.reshape(b, s, D_MODEL) @ w_out


def fourier_mix(xn, w_out):
    b, s, _ = xn.shape
    g = xn.reshape(b, s, C_GROUPS, C_GROUP_DIM).astype(F32)
    mixed = jnp.fft.fft2(g, axes=(1, 3), norm="ortho").real
    return mixed.reshape(b, s, D_MODEL).astype(xn.dtype) @ w_out


def memory_cross_attention(xn, mem_n, w_q, w_kv, w_out):
    b, s, _ = xn.shape
    m = mem_n.shape[1]
    q = (xn @ w_q).reshape(b, s, X_HEADS, X_HEAD_DIM) * (X_HEAD_DIM ** -0.5)
    k, v = jnp.split(mem_n @ w_kv, 2, axis=-1)
    k = k.reshape(b, m, X_HEADS, X_HEAD_DIM)
    v = v.reshape(b, m, X_HEADS, X_HEAD_DIM)
    scores = jnp.einsum('bqhd,bmhd->bhqm', q, k, preferred_element_type=F32)
    p = jax.nn.softmax(scores, axis=-1).astype(v.dtype)
    o = jnp.einsum('bhqm,bmhd->bqhd', p, v).reshape(b, s, X_WIDTH)
    return o @ w_out


def encoder_trunk(x, mem, p):
    for i in range(DEPTH):
        kind, slot = i % N_MIXERS, i // N_MIXERS
        h = rmsnorm(x, p["ln_pre"][i, 0])
        f = swiglu(h, p["ffn_w_gate"][i, 0], p["ffn_w_up"][i, 0], p["ffn_w_down"][i, 0])
        x = x + 0.5 * rmsnorm(f, p["ln_post"][i, 0])
        h = rmsnorm(x, p["ln_pre"][i, 1])
        if kind == 0:
            m = chunked_gmlp(h, p["a_w_in"][slot], p["a_ln_g"][slot], p["a_ln_b"][slot],
                             p["a_w_s"][slot], p["a_b_s"][slot], p["a_w_out"][slot])
        elif kind == 1:
            m = diff_attention(h, p["b_w_qkv"][slot], p["b_lam_q1"][slot], p["b_lam_k1"][slot],
                               p["b_lam_q2"][slot], p["b_lam_k2"][slot], p["b_subln"][slot],
                               p["b_w_out"][slot], i)
        else:
            m = fourier_mix(h, p["c_w_out"][slot])
        x = x + rmsnorm(m, p["ln_post"][i, 1])
        h = rmsnorm(x, p["ln_pre"][i, 2])
        mem_n = rmsnorm(mem, p["ln_mem"][i])
        c = memory_cross_attention(h, mem_n, p["x_w_q"][i], p["x_w_kv"][i], p["x_w_out"][i])
        x = x + rmsnorm(c, p["ln_post"][i, 2])
        h = rmsnorm(x, p["ln_pre"][i, 3])
        f = swiglu(h, p["ffn_w_gate"][i, 1], p["ffn_w_up"][i, 1], p["ffn_w_down"][i, 1])
        x = x + 0.5 * rmsnorm(f, p["ln_post"][i, 3])
    return x


def _normal(key, shape, scale):
    return jax.random.normal(key, shape, F32) * scale


def setup_inputs(seed: int = 0) -> dict:
    key = jax.random.key(seed)
    ks = jax.random.split(key, 27)
    D = D_MODEL
    return {
        "x_prompt": _normal(ks[0], (BATCH, SEQ, D), 1.0),
        "x_sample": _normal(ks[1], (DEC_BATCH, DEC_SEQ, D), 1.0),
        "mem_prompt": _normal(ks[2], (BATCH, N_MEM, D), 1.0),
        "mem_sample": _normal(ks[3], (DEC_BATCH, N_MEM, D), 1.0),
        "ln_pre": 1.0 + _normal(ks[4], (DEPTH, 4, D), 0.02),
        "ln_post": 1.0 + _normal(ks[5], (DEPTH, 4, D), 0.02),
        "ln_mem": 1.0 + _normal(ks[6], (DEPTH, D), 0.02),
        "ffn_w_gate": _normal(ks[7], (DEPTH, 2, D, D_FF), D ** -0.5),
        "ffn_w_up": _normal(ks[8], (DEPTH, 2, D, D_FF), D ** -0.5),
        "ffn_w_down": _normal(ks[9], (DEPTH, 2, D_FF, D), D_FF ** -0.5),
        "a_w_in": _normal(ks[10], (N_A_LAYERS, D, 2 * A_WIDTH), D ** -0.5),
        "a_ln_g": 1.0 + _normal(ks[11], (N_A_LAYERS, A_WIDTH), 0.02),
        "a_ln_b": _normal(ks[12], (N_A_LAYERS, A_WIDTH), 0.02),
        "a_w_s": _normal(ks[13], (N_A_LAYERS, A_GROUPS, CHUNK, CHUNK), CHUNK ** -0.5),
        "a_b_s": 1.0 + _normal(ks[14], (N_A_LAYERS, A_GROUPS, CHUNK), 0.02),
        "a_w_out": _normal(ks[15], (N_A_LAYERS, A_WIDTH, D), A_WIDTH ** -0.5),
        "b_w_qkv": _normal(ks[16], (N_B_LAYERS, D, 3 * D), D ** -0.5),
        "b_lam_q1": _normal(ks[17], (N_B_LAYERS, B_HEAD_DIM), 0.1),
        "b_lam_k1": _normal(ks[18], (N_B_LAYERS, B_HEAD_DIM), 0.1),
        "b_lam_q2": _normal(ks[19], (N_B_LAYERS, B_HEAD_DIM), 0.1),
        "b_lam_k2": _normal(ks[20], (N_B_LAYERS, B_HEAD_DIM), 0.1),
        "b_subln": 1.0 + _normal(ks[21], (N_B_LAYERS, B_VALUE_DIM), 0.02),
        "b_w_out": _normal(ks[22], (N_B_LAYERS, D, D), D ** -0.5),
        "c_w_out": _normal(ks[23], (N_C_LAYERS, D, D), D ** -0.5),
        "x_w_q": _normal(ks[24], (DEPTH, D, X_WIDTH), D ** -0.5),
        "x_w_kv": _normal(ks[25], (DEPTH, D, 2 * X_WIDTH), D ** -0.5),
        "x_w_out": _normal(ks[26], (DEPTH, X_WIDTH, D), X_WIDTH ** -0.5),
    }


def reference(x_prompt, x_sample, mem_prompt, mem_sample, ln_pre, ln_post, ln_mem,
              ffn_w_gate, ffn_w_up, ffn_w_down, a_w_in, a_ln_g, a_ln_b, a_w_s, a_b_s, a_w_out,
              b_w_qkv, b_lam_q1, b_lam_k1, b_lam_q2, b_lam_k2, b_subln, b_w_out, c_w_out,
              x_w_q, x_w_kv, x_w_out):
    params = {
        "ln_pre": ln_pre, "ln_post": ln_post, "ln_mem": ln_mem,
        "ffn_w_gate": ffn_w_gate, "ffn_w_up": ffn_w_up, "ffn_w_down": ffn_w_down,
        "a_w_in": a_w_in, "a_ln_g": a_ln_g, "a_ln_b": a_ln_b, "a_w_s": a_w_s, "a_b_s": a_b_s,
        "a_w_out": a_w_out,
        "b_w_qkv": b_w_qkv, "b_lam_q1": b_lam_q1, "b_lam_k1": b_lam_k1, "b_lam_q2": b_lam_q2,
        "b_lam_k2": b_lam_k2, "b_subln": b_subln, "b_w_out": b_w_out,
        "c_w_out": c_w_out,
        "x_w_q": x_w_q, "x_w_kv": x_w_kv, "x_w_out": x_w_out,
    }
    y_prompt = encoder_trunk(x_prompt, mem_prompt, params)
    y_sample = encoder_trunk(x_sample, mem_sample, params)
    return (y_prompt, y_sample)
```

```cpp
#include <hip/hip_runtime.h>
#include <cstdio>
#include <cstdint>

#ifndef MK_PER_PHASE
#define MK_PER_PHASE 0
#endif

#define LAS __attribute__((address_space(3)))
#define GAS __attribute__((address_space(1)))
typedef unsigned short bf16_t;
typedef short bf16x8 __attribute__((ext_vector_type(8)));
typedef short s16x4 __attribute__((ext_vector_type(4)));
typedef float f32x2 __attribute__((ext_vector_type(2)));
typedef float f32x4 __attribute__((ext_vector_type(4)));
typedef float f32x16 __attribute__((ext_vector_type(16)));
typedef unsigned u32x2 __attribute__((ext_vector_type(2)));
typedef unsigned u32x4 __attribute__((ext_vector_type(4)));

constexpr int D = 2048, NTOK = 40960, NPROMPT = 8192, SSAMP = 4096, DFF = 5504, NMEMTOK = 2304, NLAYER = 4;
constexpr int NWAVES = 8, NTHREADS = 512;

constexpr size_t MiB = 1u << 20;
constexpr size_t WS_CTL = 0, CTL_ZERO_BYTES = 1 * MiB;
constexpr size_t WS_ROPE_COS = 1 * MiB, WS_ROPE_SIN = WS_ROPE_COS + 512 * 1024;
constexpr size_t WS_CS = 2 * MiB;
constexpr size_t WS_WSP = 2 * MiB + 512 * 1024;
constexpr size_t WS_STATS = 3 * MiB;
constexpr size_t WS_KV = 4 * MiB;
constexpr size_t WS_MEMN = 22 * MiB;
constexpr size_t WS_AWIN = 58 * MiB;
constexpr size_t WS_AWOUT = 90 * MiB;
constexpr size_t WS_BWQKV = 106 * MiB;
constexpr size_t WS_BWOUT = 130 * MiB;
constexpr size_t WS_CWOUT = 138 * MiB;
constexpr size_t WS_XWQ = 146 * MiB;
constexpr size_t WS_XWKV = 154 * MiB;
constexpr size_t WS_XWOUT = 170 * MiB;
constexpr size_t WS_W1 = 178 * MiB;
constexpr size_t WS_WD = 221 * MiB;
constexpr size_t WS_H = 244 * MiB;
constexpr size_t WS_A = 404 * MiB;
constexpr size_t WS_B = 884 * MiB;
constexpr size_t WS_END = 1204 * MiB;
constexpr int CW_BAR = 4096;

constexpr int RING_BYTES = 131072;
constexpr int MISC_OFF = RING_BYTES + 320;
constexpr int LDS_BYTES = 147456;

__device__ __forceinline__ unsigned f2bf(float f) { unsigned u = __builtin_bit_cast(unsigned, f); return (u + 0x7fffu + ((u >> 16) & 1u)) >> 16; }
__device__ __forceinline__ unsigned cvt_pk_bf16(float lo, float hi) { unsigned r; asm volatile("v_cvt_pk_bf16_f32 %0, %1, %2" : "=v"(r) : "v"(lo), "v"(hi)); return r; }
__device__ __forceinline__ float bf_lo(unsigned w) { return __builtin_bit_cast(float, w << 16); }
__device__ __forceinline__ float bf_hi(unsigned w) { return __builtin_bit_cast(float, w & 0xffff0000u); }
__device__ __forceinline__ float wave_sum(float v, int lane) {
#pragma unroll
    for (int o = 1; o < 64; o <<= 1) v += __builtin_bit_cast(float, __builtin_amdgcn_ds_bpermute((lane ^ o) << 2, __builtin_bit_cast(int, v)));
    return v;
}
__device__ __forceinline__ int lane_id_asm() { int l; asm volatile("v_mbcnt_lo_u32_b32 %0, -1, 0\n\tv_mbcnt_hi_u32_b32 %0, -1, %0" : "=v"(l)); return l; }
#define LDS_WAIT() asm volatile("s_waitcnt lgkmcnt(0)" ::: "memory")
#define VM_WAIT() asm volatile("s_waitcnt vmcnt(0)" ::: "memory")

namespace pg8 {
constexpr int BM = 256, BK = 64, HALF = 128, HTB = HALF * BK * 2, STAGE_BYTES = 8 * HTB, NXCD = 8, WGM = 8;
__host__ __device__ __forceinline__ int lds_byte(int r, int c) { const int st = (r >> 4) * 2 + (c >> 5), rr = r & 15, cc = c & 31, ob = rr * 64 + cc * 2; return st * 1024 + (ob ^ (((ob >> 9) & 1) << 5)); }
__host__ __device__ __forceinline__ void stage_rc(int b, int& R, int& C) { const int st = b / 1024, sb = b % 1024, swz = sb ^ (((sb >> 9) & 1) << 5); R = (st >> 1) * 16 + swz / 64; C = (st & 1) * 32 + (swz % 64) / 2; }
__host__ __device__ __forceinline__ int perm32(int rho) { const int n = rho >> 4, i = rho & 15; return 8 * (i >> 2) + 4 * n + (i & 3); }

struct Unit { int pm, pn, z, ldc; size_t offA, offB, offC; };

struct StdOrder {
    int nM, nN, nwg, G, c, ldc; size_t sA, sB, sCm, sCn;
    __device__ void init(int M, int N, int lda, int ldb, int ldc_, int G_, int c_, int cn = 256) { nM = M / BM; nN = N / BM; nwg = nM * nN; G = G_; c = c_; ldc = ldc_; sA = (size_t)BM * lda; sB = (size_t)BM * ldb; sCm = (size_t)BM * ldc_; sCn = (size_t)cn; }
    __device__ __forceinline__ bool next(int i, Unit& u) const {
        const long L = (long)i * G + c; if (L >= nwg) return false;
        int wgid = (int)L; { const int q = nwg / NXCD, r = nwg % NXCD, xcd = wgid % NXCD, off = wgid / NXCD; wgid = (xcd < r ? xcd * (q + 1) : r * (q + 1) + (xcd - r) * q) + off; }
        const int nig = WGM * nN, gid = wgid / nig, fm = gid * WGM, gsz = (nM - fm) < WGM ? (nM - fm) : WGM;
        u.pm = fm + ((wgid % nig) % gsz); u.pn = (wgid % nig) / gsz; u.z = 0; u.ldc = ldc;
        u.offA = (size_t)u.pm * sA; u.offB = (size_t)u.pn * sB; u.offC = (size_t)u.pm * sCm + (size_t)u.pn * sCn; return true;
    }
};
struct BatchOrder {
    int nM, nN, nZ, G, c, ldc; size_t sAm, sAz, sBn, sBz, sCm, sCn, sCz;
    __device__ __forceinline__ bool next(int i, Unit& u) const {
        const long L = (long)i * G + c; const int per = nM * nN; if (L >= (long)per * nZ) return false;
        const int z = (int)(L / per), r = (int)(L % per); u.z = z; u.pm = r % nM; u.pn = r / nM; u.ldc = ldc;
        u.offA = (size_t)u.pm * sAm + (size_t)z * sAz; u.offB = (size_t)u.pn * sBn + (size_t)z * sBz; u.offC = (size_t)u.pm * sCm + (size_t)u.pn * sCn + (size_t)z * sCz; return true;
    }
};
struct F1Order {
    int G, c;
    __device__ __forceinline__ bool next(int i, Unit& u) const {
        const long L = (long)i * G + c; if (L >= 2560) return false;
        const int g = (int)(L / 320), r = (int)(L % 320); u.z = g; u.pm = r & 1; u.pn = r >> 1;
        u.offA = (size_t)u.pm * 256 * 256; u.offB = (size_t)u.pn * 256 * 2048 + (size_t)g * 256;
        if (u.pn < 32) { u.ldc = 16384; u.offC = (size_t)(g * 256) * 16384 + (size_t)u.pm * 8192 + (size_t)u.pn * 256; }
        else { const int rr = u.pn - 32, bb = rr >> 4, s0 = (rr & 15) * 256; u.ldc = 8192; u.offC = (size_t)2048 * 16384 + (size_t)bb * 2048 * 8192 + (size_t)(g * 256) * 8192 + (size_t)u.pm * 4096 + s0; }
        return true;
    }
};

__device__ __forceinline__ f32x2 gelu_pk(f32x2 v) {
    const f32x2 av = __builtin_elementwise_abs(v), d = av * 0.2316418882f + 1.0f;
    f32x2 t; t.x = __builtin_amdgcn_rcpf(d.x); t.y = __builtin_amdgcn_rcpf(d.y);
    f32x2 q = t * 0.5307027145f + (-0.7265760135f); q = q * t + 0.7107068705f; q = q * t + (-0.142248368f); q = q * t + 0.127414796f; q = q * t;
    const f32x2 s = (v * v) * (-0.72134752044f);
    f32x2 e; e.x = __builtin_amdgcn_exp2f(s.x); e.y = __builtin_amdgcn_exp2f(s.y);
    const f32x2 m = v * (q * e), r = v - m;
    f32x2 o; o.x = v.x < 0.f ? m.x : r.x; o.y = v.y < 0.f ? m.y : r.y; return o;
}
template <int ACT  > struct EpiBf16 {
    bf16_t* O; float scale;
    __device__ __forceinline__ void operator()(const f32x4 (&acc)[2][2][4][2], const Unit& u, int wr, int wc, int fr, int fq) const {
        bf16_t* base = O + u.offC + (size_t)(wr * 64 + fr) * u.ldc + wc * 32 + 8 * fq;
#pragma unroll
        for (int ai = 0; ai < 2; ++ai)
#pragma unroll
            for (int m = 0; m < 4; ++m) { bf16_t* rowp = base + (size_t)(ai * HALF + m * 16) * u.ldc;
#pragma unroll
                for (int bj = 0; bj < 2; ++bj) { f32x4 v0 = acc[ai][bj][m][0], v1 = acc[ai][bj][m][1];
                    if (ACT == 1) { f32x2 a = gelu_pk((f32x2){v0[0], v0[1]}), b = gelu_pk((f32x2){v0[2], v0[3]}), c = gelu_pk((f32x2){v1[0], v1[1]}), d = gelu_pk((f32x2){v1[2], v1[3]});
                        v0 = (f32x4){a.x, a.y, b.x, b.y}; v1 = (f32x4){c.x, c.y, d.x, d.y}; }
                    v0 = v0 * scale; v1 = v1 * scale; u32x4 w; w.x = cvt_pk_bf16(v0[0], v0[1]); w.y = cvt_pk_bf16(v0[2], v0[3]); w.z = cvt_pk_bf16(v1[0], v1[1]); w.w = cvt_pk_bf16(v1[2], v1[3]);
                    *(u32x4*)(rowp + bj * HALF) = w; } }
    }
};
struct EpiSwiGLU {
    bf16_t* O;
    __device__ __forceinline__ void operator()(const f32x4 (&acc)[2][2][4][2], const Unit& u, int wr, int wc, int fr, int fq) const {
        bf16_t* base = O + (size_t)(u.pm * BM + wr * 64 + fr) * DFF + u.pn * 128 + wc * 32 + 8 * fq;
#pragma unroll
        for (int ai = 0; ai < 2; ++ai)
#pragma unroll
            for (int m = 0; m < 4; ++m) { bf16_t* rowp = base + (size_t)(ai * HALF + m * 16) * DFF; float r[8];
#pragma unroll
                for (int n = 0; n < 2; ++n)
#pragma unroll
                    for (int j = 0; j < 4; ++j) { const float g = acc[ai][0][m][n][j], up = acc[ai][1][m][n][j];
                        const float sg = g * __builtin_amdgcn_rcpf(1.0f + __builtin_amdgcn_exp2f(-1.4426950408889634f * g)); r[n * 4 + j] = sg * up; }
                u32x4 w; w.x = cvt_pk_bf16(r[0], r[1]); w.y = cvt_pk_bf16(r[2], r[3]); w.z = cvt_pk_bf16(r[4], r[5]); w.w = cvt_pk_bf16(r[6], r[7]);
                *(u32x4*)rowp = w; }
    }
};
struct EpiQKV {
    bf16_t* O; const float* cosT; const float* sinT;
    __device__ __forceinline__ void operator()(const f32x4 (&acc)[2][2][4][2], const Unit& u, int wr, int wc, int fr, int fq) const {
        const int row0 = u.pm * BM + wr * 64 + fr;
        bf16_t* base = O + (size_t)row0 * 6144 + u.pn * BM + wc * 32 + 8 * fq;
        const bool rot = (u.pn < 16) && (wc == 0);
        const float sgn = (fq < 2) ? -1.0f : 1.0f;
#pragma unroll
        for (int ai = 0; ai < 2; ++ai)
#pragma unroll
            for (int m = 0; m < 4; ++m) { const int row = row0 + ai * HALF + m * 16; bf16_t* rowp = base + (size_t)(ai * HALF + m * 16) * 6144;
                f32x4 cs[2], sn[2];
                if (rot) { const int pos = row < NPROMPT ? row : (row & (SSAMP - 1)); const int to = pos * 16 + 8 * (fq & 1);
                    cs[0] = *(const f32x4*)(cosT + to); cs[1] = *(const f32x4*)(cosT + to + 4); sn[0] = *(const f32x4*)(sinT + to); sn[1] = *(const f32x4*)(sinT + to + 4); }
#pragma unroll
                for (int bj = 0; bj < 2; ++bj) { f32x4 v0 = acc[ai][bj][m][0], v1 = acc[ai][bj][m][1];
                    if (rot) {
#pragma unroll
                        for (int j = 0; j < 4; ++j) { const unsigned b0 = __builtin_bit_cast(unsigned, v0[j]), b1 = __builtin_bit_cast(unsigned, v1[j]);
                            const auto r0 = __builtin_amdgcn_permlane32_swap(b0, b0, false, false); const auto r1 = __builtin_amdgcn_permlane32_swap(b1, b1, false, false);
                            const float p0 = __builtin_bit_cast(float, fq < 2 ? r0[1] : r0[0]), p1 = __builtin_bit_cast(float, fq < 2 ? r1[1] : r1[0]);
                            v0[j] = v0[j] * cs[0][j] + sgn * p0 * sn[0][j]; v1[j] = v1[j] * cs[1][j] + sgn * p1 * sn[1][j]; } }
                    u32x4 w; w.x = cvt_pk_bf16(v0[0], v0[1]); w.y = cvt_pk_bf16(v0[2], v0[3]); w.z = cvt_pk_bf16(v1[0], v1[1]); w.w = cvt_pk_bf16(v1[2], v1[3]);
                    *(u32x4*)(rowp + bj * HALF) = w; } }
    }
};

template <class Epi, class Sched>
__device__ __forceinline__ void gemm_phase(const int tid, LAS unsigned char* lds, const bf16_t* Abase, const bf16_t* Bbase, const int lda, const int ldb, const int nt, const Sched& S, const Epi& E) {
    const int wid = __builtin_amdgcn_readfirstlane(tid >> 6), lane = tid & 63, wr = wid >> 2, wc = wid & 3, fr = lane & 15, fq = lane >> 4;
    unsigned voffA[2], voffB[2];
#pragma unroll
    for (int i = 0; i < 2; ++i) { int R, C; stage_rc(tid * 16 + i * 8192, R, C); const int Rb = (R & ~31) + perm32(R & 31);
        voffA[i] = (unsigned)(R * lda + C) * 2u; voffB[i] = (unsigned)(Rb * ldb + C) * 2u; }
    const size_t kstep = (size_t)(BK * 2);
    const size_t hstepA = (size_t)HALF * lda * 2, hstepB = (size_t)HALF * ldb * 2;
    const unsigned ldsw = (unsigned)wid * 1024u;
    const int aoff = lds_byte(wr * 64 + fr, fq * 8), boff = lds_byte(wc * 32 + fr, fq * 8);
#define PG8_SA(b, h) (((b) * 2 + (h)) * HTB)
#define PG8_SB(b, h) ((4 + (b) * 2 + (h)) * HTB)
#define PG8_STAGE(bufoff, gbase, voff) do { _Pragma("unroll") for (int _i = 0; _i < 2; ++_i) \
        __builtin_amdgcn_global_load_lds((const unsigned*)((const char*)(gbase) + (voff)[_i]), (LAS unsigned*)(lds + (bufoff) + ldsw + _i * 8192), 16, 0, 0); } while (0)
#define PG8_LDA(dst, b, h) do { _Pragma("unroll") for (int m = 0; m < 4; ++m) _Pragma("unroll") for (int k = 0; k < 2; ++k) dst[m][k] = *(const LAS bf16x8*)(lds + PG8_SA(b, h) + aoff + m * 2048 + k * 1024); } while (0)
#define PG8_LDB(dst, b, h) do { _Pragma("unroll") for (int n = 0; n < 2; ++n) _Pragma("unroll") for (int k = 0; k < 2; ++k) dst[n][k] = *(const LAS bf16x8*)(lds + PG8_SB(b, h) + boff + n * 2048 + k * 1024); } while (0)
#define PG8_MMA(ai, bj, At, Bt) do { __builtin_amdgcn_s_setprio(1); _Pragma("unroll") for (int m = 0; m < 4; ++m) _Pragma("unroll") for (int n = 0; n < 2; ++n) _Pragma("unroll") for (int k = 0; k < 2; ++k) \
        acc[ai][bj][m][n] = __builtin_amdgcn_mfma_f32_16x16x32_bf16(Bt[n][k], At[m][k], acc[ai][bj][m][n], 0, 0, 0); __builtin_amdgcn_s_setprio(0); } while (0)
#define PG8_WAIT_V(n) asm volatile("s_waitcnt vmcnt(" #n ")" ::: "memory")
#define PG8_WAIT_L(n) asm volatile("s_waitcnt lgkmcnt(" #n ")" ::: "memory")
#define PG8_BAR __builtin_amdgcn_s_barrier()
#define PG8_SCHED __builtin_amdgcn_sched_barrier(0)
    Unit cur, nxt; int ui = 0;
    if (!S.next(0, cur)) return;
    f32x4 acc[2][2][4][2];
#pragma unroll
    for (int a = 0; a < 2; ++a)
#pragma unroll
        for (int b = 0; b < 2; ++b)
#pragma unroll
            for (int m = 0; m < 4; ++m)
#pragma unroll
                for (int n = 0; n < 2; ++n) acc[a][b][m][n] = (f32x4){0.f, 0.f, 0.f, 0.f};
    bf16x8 At[4][2], B0[2][2], B1[2][2];
    const char* cA = (const char*)(Abase + cur.offA); const char* cB = (const char*)(Bbase + cur.offB);
    PG8_STAGE(PG8_SB(0, 0), cB, voffB); PG8_STAGE(PG8_SB(0, 1), cB + hstepB, voffB); PG8_STAGE(PG8_SA(0, 0), cA, voffA); PG8_STAGE(PG8_SA(0, 1), cA + hstepA, voffA);
    if (wr == 1) PG8_BAR;
    PG8_WAIT_V(2); PG8_BAR;
    PG8_STAGE(PG8_SB(1, 0), cB + kstep, voffB); PG8_STAGE(PG8_SA(1, 0), cA + kstep, voffA); PG8_STAGE(PG8_SB(1, 1), cB + hstepB + kstep, voffB);
    PG8_WAIT_V(6); PG8_BAR;
    for (;;) {
        const bool has_next = S.next(ui + 1, nxt);
        const char* nA = has_next ? (const char*)(Abase + nxt.offA) : cA; const char* nB = has_next ? (const char*)(Bbase + nxt.offB) : cB;
        for (int t = 0; t < nt; t += 2) {
            const bool last = (t == nt - 2);
            const char* a1 = cA + (size_t)(t + 1) * kstep;
            const char* a2 = last ? nA : cA + (size_t)(t + 2) * kstep; const char* b2 = last ? nB : cB + (size_t)(t + 2) * kstep;
            const char* a3 = a2 + kstep; const char* b3 = b2 + kstep;
            PG8_LDB(B0, 0, 0); PG8_LDB(B1, 0, 1); PG8_SCHED; PG8_LDA(At, 0, 0); PG8_STAGE(PG8_SA(1, 1), a1 + hstepA, voffA);
            PG8_WAIT_V(8); PG8_WAIT_L(0); PG8_BAR; PG8_MMA(0, 0, At, B0); PG8_MMA(0, 1, At, B1); PG8_BAR; PG8_SCHED;
            PG8_LDA(At, 0, 1); PG8_STAGE(PG8_SB(0, 0), b2, voffB); PG8_STAGE(PG8_SB(0, 1), b2 + hstepB, voffB); PG8_STAGE(PG8_SA(0, 0), a2, voffA);
            PG8_WAIT_V(8); PG8_WAIT_L(0); PG8_BAR; PG8_MMA(1, 0, At, B0); PG8_MMA(1, 1, At, B1); PG8_BAR; PG8_SCHED;
            PG8_LDB(B0, 1, 0); PG8_LDB(B1, 1, 1); PG8_SCHED; PG8_LDA(At, 1, 0); PG8_STAGE(PG8_SA(0, 1), a2 + hstepA, voffA);
            PG8_WAIT_V(8); PG8_WAIT_L(0); PG8_BAR; PG8_MMA(0, 0, At, B0); PG8_MMA(0, 1, At, B1); PG8_BAR; PG8_SCHED;
            PG8_LDA(At, 1, 1); PG8_STAGE(PG8_SB(1, 0), b3, voffB); PG8_STAGE(PG8_SB(1, 1), b3 + hstepB, voffB); PG8_STAGE(PG8_SA(1, 0), a3, voffA);
            PG8_WAIT_V(8); PG8_WAIT_L(0); PG8_BAR; PG8_MMA(1, 0, At, B0); PG8_MMA(1, 1, At, B1); PG8_BAR; PG8_SCHED;
        }
        if (wr == 0) PG8_BAR;
        { const int ln2 = lane_id_asm(); E(acc, cur, wr, wc, ln2 & 15, ln2 >> 4); }
        if (!has_next) break;
#pragma unroll
        for (int a = 0; a < 2; ++a)
#pragma unroll
            for (int b = 0; b < 2; ++b)
#pragma unroll
                for (int m = 0; m < 4; ++m)
#pragma unroll
                    for (int n = 0; n < 2; ++n) acc[a][b][m][n] = (f32x4){0.f, 0.f, 0.f, 0.f};
        cur = nxt; cA = nA; cB = nB; ++ui;
        if (wr == 1) PG8_BAR;
    }
    PG8_WAIT_V(0);
    PG8_BAR;
#undef PG8_SA
#undef PG8_SB
#undef PG8_STAGE
#undef PG8_LDA
#undef PG8_LDB
#undef PG8_MMA
#undef PG8_WAIT_V
#undef PG8_WAIT_L
#undef PG8_BAR
#undef PG8_SCHED
}
}

namespace att {
constexpr int AD = 128, NW = 8, QBLK = 32, KVBLK = 64;
constexpr float SCALE = 0.088388347648318440f;
constexpr float THR = 8.f;
constexpr size_t SHM_V = KVBLK * AD * 2, SHM_K = KVBLK * AD * 2, SHM_ATTN = 2 * SHM_V + 2 * SHM_K + NW * 64 * 4;
#define KSWZ(row, colB) ((row) * 256 + ((colB) ^ (((row) & 7) << 4)))
#define SBAR() __builtin_amdgcn_sched_barrier(0)
__device__ __forceinline__ int crow(int r, int hi) { return (r & 3) + 8 * (r >> 2) + 4 * hi; }
__device__ __forceinline__ unsigned cvtpk(float lo, float hi) { unsigned r; asm volatile("v_cvt_pk_bf16_f32 %0, %1, %2" : "=v"(r) : "v"(lo), "v"(hi)); return r; }
__device__ __forceinline__ void partialSM(f32x16& p0, f32x16& p1, float& m_reg, float& mn, float& alpha) {
  constexpr float C = SCALE * 1.4426950408889634f;
  float pmax = p0[0]; for (int r = 1; r < 16; ++r) pmax = fmaxf(pmax, p0[r]); for (int r = 0; r < 16; ++r) pmax = fmaxf(pmax, p1[r]);
  { auto rr = __builtin_amdgcn_permlane32_swap(__float_as_uint(pmax), __float_as_uint(pmax), false, false);
    pmax = fmaxf(__uint_as_float(rr[0]), __uint_as_float(rr[1])); }
  if (__builtin_expect(__all(pmax - m_reg <= THR / SCALE), 1)) { mn = m_reg; alpha = 1.f; }
  else { mn = fmaxf(m_reg, pmax); alpha = __builtin_amdgcn_exp2f((m_reg - mn) * C); m_reg = mn; }
  float mnC = -mn * C;
  for (int r = 0; r < 16; ++r) p0[r] = fmaf(p0[r], C, mnC); for (int r = 0; r < 16; ++r) p1[r] = fmaf(p1[r], C, mnC);
  for (int r = 0; r < 16; ++r) p0[r] = __builtin_amdgcn_exp2f(p0[r]);
}
__device__ __forceinline__ void finishSM(f32x16& p0, f32x16& p1, float alpha, float& l_reg, bf16x8& pa0, bf16x8& pa1, bf16x8& pa2, bf16x8& pa3) {
  for (int r = 0; r < 16; ++r) p1[r] = __builtin_amdgcn_exp2f(p1[r]);
  float ps = 0; for (int r = 0; r < 16; ++r) ps += p0[r]; for (int r = 0; r < 16; ++r) ps += p1[r];
  { auto rr = __builtin_amdgcn_permlane32_swap(__float_as_uint(ps), __float_as_uint(ps), false, false);
    ps = __uint_as_float(rr[0]) + __uint_as_float(rr[1]); }
  l_reg = l_reg * alpha + ps;
#define PK4(P, BASE, OUT) do { unsigned a0 = cvtpk(P[BASE + 0], P[BASE + 1]), a1 = cvtpk(P[BASE + 2], P[BASE + 3]);   \
    unsigned b0 = cvtpk(P[BASE + 4], P[BASE + 5]), b1 = cvtpk(P[BASE + 6], P[BASE + 7]);                              \
    auto r0 = __builtin_amdgcn_permlane32_swap(a0, b0, false, false); auto r1 = __builtin_amdgcn_permlane32_swap(a1, b1, false, false); \
    u32x4 w = {r0[0], r1[0], r0[1], r1[1]}; OUT = *reinterpret_cast<bf16x8*>(&w); } while (0)
  PK4(p0, 0, pa0); PK4(p0, 8, pa1); PK4(p1, 0, pa2); PK4(p1, 8, pa3);
#undef PK4
}
__device__ __forceinline__ void qkt(f32x16& p0, f32x16& p1, const bf16_t* Ks, const bf16x8* qr, int r32, int hi) {
  p0 = f32x16{}; p1 = f32x16{};
  for (int d0 = 0; d0 < 8; ++d0) { int cb = (d0 * 16 + hi * 8) * 2;
    bf16x8 b0 = *reinterpret_cast<const bf16x8*>((const char*)Ks + KSWZ(r32, cb));
    bf16x8 b1 = *reinterpret_cast<const bf16x8*>((const char*)Ks + KSWZ(32 + r32, cb));
    p0 = __builtin_amdgcn_mfma_f32_32x32x16_bf16(b0, qr[d0], p0, 0, 0, 0);
    p1 = __builtin_amdgcn_mfma_f32_32x32x16_bf16(b1, qr[d0], p1, 0, 0, 0); }
}
__device__ __forceinline__ int v_st(int k, int c) { const int kk = (k & ~0xC) | ((k & 4) << 1) | ((k & 8) >> 1); return ((kk >> 3) * 4 + (c >> 5)) * 512 + ((kk & 7) * 32 + (c & 31)) * 2; }
__device__ __forceinline__ int v_rd_base(int lane) { return ((lane & 3) << 3) | (((lane >> 2) & 3) << 6) | (((lane >> 4) & 1) << 5) | (((lane >> 5) & 1) << 8); }
constexpr int v_rd_off(int d0, int ks, int half) { return d0 * 512 + ks * 4096 + half * 2048; }
template <int OFF> __device__ __forceinline__ s16x4 tr_read(int vb) {
  s16x4 r; asm volatile("ds_read_b64_tr_b16 %0, %1 offset:%2" : "=&v"(r) : "v"(vb), "i"(OFF) : "memory"); return r;
}
template <int D0> __device__ __forceinline__ void pv_one(f32x16& od, int vb, bf16x8 pa0, bf16x8 pa1, bf16x8 pa2, bf16x8 pa3) {
  const s16x4 l0 = tr_read<v_rd_off(D0, 0, 0)>(vb), h0 = tr_read<v_rd_off(D0, 0, 1)>(vb), l1 = tr_read<v_rd_off(D0, 1, 0)>(vb), h1 = tr_read<v_rd_off(D0, 1, 1)>(vb);
  const s16x4 l2 = tr_read<v_rd_off(D0, 2, 0)>(vb), h2 = tr_read<v_rd_off(D0, 2, 1)>(vb), l3 = tr_read<v_rd_off(D0, 3, 0)>(vb), h3 = tr_read<v_rd_off(D0, 3, 1)>(vb);
  asm volatile("s_waitcnt lgkmcnt(0)" ::: "memory"); SBAR();
#define PK(L, H) (bf16x8){L[0], L[1], L[2], L[3], H[0], H[1], H[2], H[3]}
  od = __builtin_amdgcn_mfma_f32_32x32x16_bf16(pa0, PK(l0, h0), od, 0, 0, 0);
  od = __builtin_amdgcn_mfma_f32_32x32x16_bf16(pa1, PK(l1, h1), od, 0, 0, 0);
  od = __builtin_amdgcn_mfma_f32_32x32x16_bf16(pa2, PK(l2, h2), od, 0, 0, 0);
  od = __builtin_amdgcn_mfma_f32_32x32x16_bf16(pa3, PK(l3, h3), od, 0, 0, 0);
#undef PK
}
__device__ __forceinline__ void pv_d0(f32x16* o, int vb, bf16x8 pa0, bf16x8 pa1, bf16x8 pa2, bf16x8 pa3) {
  pv_one<0>(o[0], vb, pa0, pa1, pa2, pa3); pv_one<1>(o[1], vb, pa0, pa1, pa2, pa3); pv_one<2>(o[2], vb, pa0, pa1, pa2, pa3); pv_one<3>(o[3], vb, pa0, pa1, pa2, pa3);
}
template <int LDQ, int LDK, int LDO>
__device__ __forceinline__ void attn_dense_body(const int tid, const bf16_t* __restrict__ Qb, const bf16_t* __restrict__ Kh, const bf16_t* __restrict__ Vh, bf16_t* __restrict__ Ob, int seq, char* lds) {
  constexpr int SDEPTH = 2;
  const int wid = tid >> 6, lane = tid & 63, r32 = lane & 31, hi = lane >> 5;
  bf16_t* V_lds = (bf16_t*)lds; bf16_t* K_lds = (bf16_t*)(lds + 2 * SHM_V);
  float* ws = (float*)(lds + 2 * SHM_V + 2 * SHM_K) + wid * 64; float* li_l = ws; float* al_l = ws + 32;
  float m_reg = -1e30f, l_reg = 0; f32x16 o[4] = {}; bf16x8 qr[8];
  const bf16_t* Qw = Qb + (long)(wid * QBLK + r32) * LDQ + hi * 8;
#pragma unroll
  for (int d0 = 0; d0 < 8; ++d0) qr[d0] = *reinterpret_cast<const bf16x8*>(Qw + d0 * 16);
  const int sr = tid >> 4, sc = (tid & 15) * 8, vst0 = v_st(sr, sc), vst1 = v_st(32 + sr, sc);
  const int vb0 = (int)(uintptr_t)V_lds + v_rd_base(lane);
  struct { bf16x8 vs0, vs1, ks0, ks1; } sr_[SDEPTH];
#define LD8(p) (*reinterpret_cast<const bf16x8*>(p))
#define SLOAD(i, k0) do { sr_[i].vs0 = LD8(&Vh[(long)((k0) + sr) * LDK + sc]); sr_[i].vs1 = LD8(&Vh[(long)((k0) + 32 + sr) * LDK + sc]); \
    sr_[i].ks0 = LD8(&Kh[(long)((k0) + sr) * LDK + sc]); sr_[i].ks1 = LD8(&Kh[(long)((k0) + 32 + sr) * LDK + sc]); } while (0)
#define SWRITE(b, i) do { *(bf16x8*)((char*)V_lds + (b) * SHM_V + vst0) = sr_[i].vs0;          \
    *(bf16x8*)((char*)V_lds + (b) * SHM_V + vst1) = sr_[i].vs1; int kc = sc * 2;               \
    *(bf16x8*)((char*)K_lds + (b) * SHM_K + KSWZ(sr, kc)) = sr_[i].ks0;                       \
    *(bf16x8*)((char*)K_lds + (b) * SHM_K + KSWZ(32 + sr, kc)) = sr_[i].ks1; } while (0)
#define SWAIT() do { asm volatile("s_waitcnt vmcnt(4)" ::: "memory"); } while (0)
#define RESC(a) do { if (__any((a) < 1.f)) { if (hi == 0) al_l[r32] = (a); asm volatile("s_waitcnt lgkmcnt(0)" ::: "memory"); \
    for (int d = 0; d < 4; ++d) for (int r = 0; r < 16; ++r) o[d][r] *= al_l[crow(r, hi)]; } } while (0)
  f32x16 pA0, pA1, pB0, pB1; float mnA, mnB, alA, alB; bf16x8 pa0, pa1, pa2, pa3; const int NT = seq / KVBLK;
  constexpr int SE = 0, SO = SDEPTH - 1;
  SLOAD(SE, 0); asm volatile("s_waitcnt vmcnt(0)" ::: "memory"); SWRITE(0, SE); __syncthreads();
  qkt(pA0, pA1, K_lds, qr, r32, hi); partialSM(pA0, pA1, m_reg, mnA, alA);
  SLOAD(SO, KVBLK); if (2 < NT) SLOAD(SE, 2 * KVBLK);
  SWAIT(); SWRITE(1, SO); __syncthreads();
  for (int j = 1; j + 1 < NT; j += 2) {
    SBAR(); qkt(pB0, pB1, (bf16_t*)((char*)K_lds + SHM_K), qr, r32, hi);
    finishSM(pA0, pA1, alA, l_reg, pa0, pa1, pa2, pa3); SBAR();
    SLOAD(SO, (j + SDEPTH) * KVBLK); SBAR();
    pv_d0(o, vb0, pa0, pa1, pa2, pa3); partialSM(pB0, pB1, m_reg, mnB, alB);
    __syncthreads(); SWAIT(); SWRITE(0, SE);
    RESC(alB); __syncthreads();
    SBAR(); qkt(pA0, pA1, K_lds, qr, r32, hi);
    finishSM(pB0, pB1, alB, l_reg, pa0, pa1, pa2, pa3); SBAR();
    if (j + 3 < NT) SLOAD(SE, (j + 1 + SDEPTH) * KVBLK); SBAR();
    pv_d0(o, vb0 + (int)SHM_V, pa0, pa1, pa2, pa3); partialSM(pA0, pA1, m_reg, mnA, alA);
    __syncthreads(); SWAIT(); SWRITE(1, SO);
    RESC(alA); __syncthreads();
  }
  SBAR(); qkt(pB0, pB1, (bf16_t*)((char*)K_lds + SHM_K), qr, r32, hi);
  finishSM(pA0, pA1, alA, l_reg, pa0, pa1, pa2, pa3); SBAR();
  pv_d0(o, vb0, pa0, pa1, pa2, pa3); partialSM(pB0, pB1, m_reg, mnB, alB);
  __syncthreads(); RESC(alB);
  finishSM(pB0, pB1, alB, l_reg, pa0, pa1, pa2, pa3); SBAR();
  pv_d0(o, vb0 + (int)SHM_V, pa0, pa1, pa2, pa3);
  if (hi == 0) li_l[r32] = l_reg; asm volatile("s_waitcnt lgkmcnt(0)" ::: "memory");
  float rli[16];
#pragma unroll
  for (int r = 0; r < 16; ++r) rli[r] = __builtin_amdgcn_rcpf(li_l[crow(r, hi)]);
  bf16_t* Ow = Ob + (long)(wid * QBLK) * LDO;
#pragma unroll
  for (int r = 0; r < 16; ++r) { int orow = crow(r, hi);
    for (int d0 = 0; d0 < 4; ++d0) Ow[(long)orow * LDO + d0 * 32 + r32] = (bf16_t)f2bf(o[d0][r] * rli[r]); }
#undef LD8
#undef SLOAD
#undef SWRITE
#undef SWAIT
#undef RESC
}
}

#define XB_TMO      128
#define XB_XCNT(j)  (256  + 64 * (j))
#define XB_XSUB(j)  (1280 + 64 * (j))
#define XB_XGEN(j)  (2304 + 64 * (j))
#define XB_TOP      3328
#define XB_TOPGEN   3392
#define XCD_BAR_WORDS 3456
#define XB_SPIN_CAP (1u << 18)
__device__ __forceinline__ unsigned xb_ld(unsigned* p)              { return __hip_atomic_load(p, __ATOMIC_RELAXED, __HIP_MEMORY_SCOPE_AGENT); }
__device__ __forceinline__ unsigned xb_add(unsigned* p, unsigned v) { return __hip_atomic_fetch_add(p, v, __ATOMIC_RELAXED, __HIP_MEMORY_SCOPE_AGENT); }
__device__ __forceinline__ unsigned xb_xcc_id() { return (unsigned)__builtin_amdgcn_s_getreg((3 << 11) | 20) & 0xFu; }
#define XB_SPIN(cond, bar) do { unsigned _sp = 0; while (cond) { __builtin_amdgcn_s_sleep(1); \
    if ((++_sp & 255u) == 0u) { if (xb_ld(&(bar)[XB_TMO])) break; if (_sp > XB_SPIN_CAP) { atomicAdd(&(bar)[XB_TMO], 1u); break; } } } } while (0)
struct XcdBarrier { unsigned* bar; unsigned x; volatile LAS unsigned* st; };
__device__ __forceinline__ XcdBarrier xcd_barrier_post(unsigned* bar, volatile LAS unsigned* st) {
    XcdBarrier b; b.bar = bar; b.x = xb_xcc_id(); b.st = st;
    if (threadIdx.x == 0) (void)xb_add(&bar[XB_XCNT(b.x)], 1u);
    return b;
}
__device__ __forceinline__ void xcd_barrier_complete(unsigned* bar, unsigned x, unsigned& nloc, unsigned& nx) {
    const unsigned G = gridDim.x * gridDim.y * gridDim.z;
    unsigned sum, cnt, mine, sp = 0u;
    for (;;) {
        sum = 0u; cnt = 0u; mine = 0u;
#pragma unroll
        for (unsigned j = 0; j < 16; ++j) { const unsigned c = xb_ld(&bar[XB_XCNT(j)]); sum += c; cnt += (c > 0u) ? 1u : 0u; mine = (j == x) ? c : mine; }
        if (sum == G) break;
        __builtin_amdgcn_s_sleep(1);
        if ((++sp & 255u) == 0u) { if (xb_ld(&bar[XB_TMO])) break; if (sp > XB_SPIN_CAP) { atomicAdd(&bar[XB_TMO], 1u); break; } }
    }
    nloc = mine > 0u ? mine : 1u; nx = cnt > 0u ? cnt : 1u;
}
__device__ __forceinline__ void xcd_barrier(const XcdBarrier& b) {
    asm volatile("s_waitcnt vmcnt(0)" ::: "memory");
    __syncthreads();
    if (threadIdx.x == 0) {
        unsigned* bar = b.bar;
        __builtin_amdgcn_s_waitcnt(0);
        unsigned nloc = b.st[0], nx = b.st[1];
        if (nloc == 0u) { xcd_barrier_complete(bar, b.x, nloc, nx); b.st[0] = nloc; b.st[1] = nx; }
        const unsigned old = xb_add(&bar[XB_XSUB(b.x)], 1u);
        const unsigned gen = old / nloc;
        if (old + 1u == (gen + 1u) * nloc) {
            __builtin_amdgcn_fence(__ATOMIC_RELEASE, "agent");
            asm volatile("s_waitcnt vmcnt(0)" ::: "memory");
            const unsigned og = xb_add(&bar[XB_TOP], 1u);
            const unsigned tg = og / nx;
            if (og + 1u == (tg + 1u) * nx) xb_add(&bar[XB_TOPGEN], 1u);
            else XB_SPIN(xb_ld(&bar[XB_TOPGEN]) == tg, bar);
            __builtin_amdgcn_fence(__ATOMIC_ACQUIRE, "agent");
            xb_add(&bar[XB_XGEN(b.x)], 1u);
            asm volatile("s_waitcnt vmcnt(0)" ::: "memory");
        } else {
            XB_SPIN(xb_ld(&bar[XB_XGEN(b.x)]) == gen, bar);
            __builtin_amdgcn_fence(__ATOMIC_ACQUIRE, "agent");
            asm volatile("s_waitcnt vmcnt(0)" ::: "memory");
        }
    }
    __syncthreads();
}

__device__ __forceinline__ void transpose_item(const float* W, int K, int N, bf16_t* WT, int mode, LAS float* scr, int item, int lane) {
    const int nblk = N / 32, kb = item / nblk, nb = item % nblk, k0 = 64 * kb, n0 = 32 * nb;
    const int r0 = mode == 0 ? n0 : ((n0 >> 7) * 256 + (n0 & 127) + (mode == 2 ? 128 : 0));
#pragma unroll 8
    for (int i = 0; i < 32; ++i) { const int kk = 2 * i + (lane >> 5); scr[kk * 33 + (lane & 31)] = W[(size_t)(k0 + kk) * N + n0 + (lane & 31)]; }
    LDS_WAIT(); asm volatile("" ::: "memory");
    const int c = lane & 7;
#pragma unroll
    for (int j = 0; j < 4; ++j) { const int n = (lane >> 3) + 8 * j; const LAS float* s = scr + (8 * c) * 33 + n;
        u32x4 o; o.x = cvt_pk_bf16(s[0 * 33], s[1 * 33]); o.y = cvt_pk_bf16(s[2 * 33], s[3 * 33]); o.z = cvt_pk_bf16(s[4 * 33], s[5 * 33]); o.w = cvt_pk_bf16(s[6 * 33], s[7 * 33]);
        *(GAS u32x4*)(WT + (size_t)(r0 + n) * K + k0 + 8 * c) = o; }
    LDS_WAIT(); asm volatile("" ::: "memory");
}
__device__ __forceinline__ void transpose_matrix(const float* W, int K, int N, bf16_t* WT, int mode, LAS float* scr, int gw, int NGW, int lane, int& base) {
    const int n = (K / 64) * (N / 32);
    int first = (gw - base % NGW + NGW) % NGW;
    for (int it = first; it < n; it += NGW) transpose_item(W, K, N, WT, mode, scr, it, lane);
    base += n;
}
__device__ __forceinline__ void convert_ffn_weights(const float* Wg, const float* Wu, const float* Wd, bf16_t* W1, bf16_t* WD, LAS float* scr, int gw, int NGW, int lane) {
    int base = 0;
    transpose_matrix(Wg, D, DFF, W1, 1, scr, gw, NGW, lane, base);
    transpose_matrix(Wu, D, DFF, W1, 2, scr, gw, NGW, lane, base);
    transpose_matrix(Wd, DFF, D, WD, 0, scr, gw, NGW, lane, base);
}

template <bool FIRST, bool HAS_F, bool HAS_H>
__device__ __forceinline__ void rowpass(const float* xp, const float* xs, float* xout, const bf16_t* f, bf16_t* hout, const float* gpost, const float* gpre, float scale, int gw, int NGW, int lane) {
    f32x4 gp[8], gn[8];
#pragma unroll
    for (int j = 0; j < 8; ++j) { gp[j] = HAS_F ? *(const f32x4*)(gpost + 256 * j + 4 * lane) : (f32x4){0.f, 0.f, 0.f, 0.f}; gn[j] = HAS_H ? *(const f32x4*)(gpre + 256 * j + 4 * lane) : (f32x4){0.f, 0.f, 0.f, 0.f}; }
    for (int row = gw; row < NTOK; row += NGW) {
        const float* xrow = FIRST ? (row < NPROMPT ? xp + (size_t)row * D : xs + (size_t)(row - NPROMPT) * D) : xout + (size_t)row * D;
        const GAS f32x4* xr = (const GAS f32x4*)xrow + lane;
        f32x4 x[8];
#pragma unroll
        for (int j = 0; j < 8; ++j) x[j] = xr[64 * j];
        if (HAS_F) {
            const GAS u32x2* fr = (const GAS u32x2*)(f + (size_t)row * D) + lane; u32x2 fv[8];
#pragma unroll
            for (int j = 0; j < 8; ++j) fv[j] = fr[64 * j];
            float ss = 0.f; f32x4 ff[8];
#pragma unroll
            for (int j = 0; j < 8; ++j) { ff[j] = (f32x4){bf_lo(fv[j].x), bf_hi(fv[j].x), bf_lo(fv[j].y), bf_hi(fv[j].y)}; ss += (ff[j].x * ff[j].x + ff[j].y * ff[j].y) + (ff[j].z * ff[j].z + ff[j].w * ff[j].w); }
            const float r = rsqrtf(wave_sum(ss, lane) * (1.0f / D) + 1e-6f) * scale;
#pragma unroll
            for (int j = 0; j < 8; ++j) x[j] = x[j] + ff[j] * r * gp[j];
        }
        GAS f32x4* xo = (GAS f32x4*)(xout + (size_t)row * D) + lane;
#pragma unroll
        for (int j = 0; j < 8; ++j) xo[64 * j] = x[j];
        if (HAS_H) {
            float s2 = 0.f;
#pragma unroll
            for (int j = 0; j < 8; ++j) s2 += (x[j].x * x[j].x + x[j].y * x[j].y) + (x[j].z * x[j].z + x[j].w * x[j].w);
            const float r2 = rsqrtf(wave_sum(s2, lane) * (1.0f / D) + 1e-6f);
            GAS u32x2* ho = (GAS u32x2*)(hout + (size_t)row * D) + lane;
#pragma unroll
            for (int j = 0; j < 8; ++j) { const f32x4 v = x[j] * r2 * gn[j]; u32x2 w; w.x = cvt_pk_bf16(v.x, v.y); w.y = cvt_pk_bf16(v.z, v.w); ho[64 * j] = w; }
        }
    }
}

__device__ __forceinline__ void sincos_d(double x, double& s, double& c) {
    const double n = rint(x * 0.63661977236758134308);
    double r = x - n * 1.57079632679489655800e+00; r = r - n * 6.12323399573676603587e-17;
    const long long q = (long long)n;
    const double r2 = r * r;
    double sp = -7.6471637318198164759e-13;
    sp = sp * r2 + 1.6059043836821614599e-10; sp = sp * r2 - 2.5052108385441718775e-08; sp = sp * r2 + 2.7557319223985890653e-06; sp = sp * r2 - 1.9841269841269841270e-04;
    sp = sp * r2 + 8.3333333333333333333e-03; sp = sp * r2 - 1.6666666666666666667e-01; const double sr = r + r * r2 * sp;
    double cp = 4.7794773323873852974e-14;
    cp = cp * r2 - 1.1470745597729724714e-11; cp = cp * r2 + 2.0876756987868098979e-09; cp = cp * r2 - 2.7557319223985890653e-07; cp = cp * r2 + 2.4801587301587301587e-05;
    cp = cp * r2 - 1.3888888888888888889e-03; cp = cp * r2 + 4.1666666666666666667e-02; cp = cp * r2 - 0.5; const double cr = 1.0 + r2 * cp;
    const int qq = (int)(q & 3);
    s = (qq == 0) ? sr : (qq == 1) ? cr : (qq == 2) ? -sr : -cr;
    c = (qq == 0) ? cr : (qq == 1) ? -sr : (qq == 2) ? -cr : sr;
}

struct Args { const float* in[27]; float* out; unsigned char* ws; int ph_lo, ph_hi; };
static_assert(sizeof(Args) == 29 * 8 + 8, "Args has no padding");

__host__ __device__ constexpr int mixer_phases(int kind) { return kind == 1 ? 4 : (kind == 0 ? 3 : 2); }
__host__ __device__ constexpr int total_phases() {
    int n = 2;
    for (int l = 0; l < NLAYER; ++l) n += 3 + mixer_phases(l % 3) + 2 + 4 + 3;
    return n;
}

typedef const __attribute__((address_space(4))) Args* KArgsP;
__global__ void __launch_bounds__(NTHREADS, 2) trunk_fwd(Args args) {
    extern __shared__ __attribute__((aligned(16))) unsigned char lds_raw[];
    LAS unsigned char* const lds = (LAS unsigned char*)lds_raw;
    volatile LAS unsigned* const MISC = (volatile LAS unsigned*)(lds + MISC_OFF);
    const int G = gridDim.x, bx = blockIdx.x;
    const int vcu = (G % 8 == 0) ? (bx % 8) * (G / 8) + bx / 8 : bx;
    const int NGW = G * NWAVES;
    const int wave_s = __builtin_amdgcn_readfirstlane((int)threadIdx.x >> 6);
    for (int u = threadIdx.x; u < (LDS_BYTES - RING_BYTES) / 4; u += NTHREADS) ((LAS unsigned*)(lds + RING_BYTES))[u] = 0u;
    __syncthreads();
    const int lo = args.ph_lo, hi = args.ph_hi;
    if (hi - lo > 1) (void)xcd_barrier_post((unsigned*)(args.ws + WS_CTL) + CW_BAR, MISC + 8);

    int ph = 0;
#define PH_BEGIN if (ph >= lo && ph < hi) { \
        KArgsP ap = (KArgsP)__builtin_amdgcn_kernarg_segment_ptr(); asm volatile("" : "+s"(ap)); \
        const int wave = wave_s; const int tid = wave_s * 64 + lane_id_asm(); \
        const int lane = tid & 63; const int gw = vcu * NWAVES + wave; \
        unsigned char* const ws = ap->ws; (void)lane; (void)gw; (void)ws;
#define PH_END } if (ph >= lo && ph + 1 < hi) { KArgsP ap2 = (KArgsP)__builtin_amdgcn_kernarg_segment_ptr(); asm volatile("" : "+s"(ap2)); \
        XcdBarrier b_; b_.bar = (unsigned*)(ap2->ws + WS_CTL) + CW_BAR; b_.x = xb_xcc_id(); b_.st = MISC + 8; xcd_barrier(b_); } ++ph;
#define WSP(T, OFF) ((T*)(ws + (OFF)))

    PH_BEGIN
        LAS float* scr = (LAS float*)(lds + wave * 16384);
        const float* a_w_in = ap->in[10]; const float* a_w_out = ap->in[15];
        int base = 0;
        for (int s = 0; s < 2; ++s) transpose_matrix(a_w_in + (size_t)s * D * 4096, D, 4096, WSP(bf16_t, WS_AWIN) + (size_t)s * 4096 * D, 0, scr, gw, NGW, lane, base);
        for (int s = 0; s < 2; ++s) transpose_matrix(a_w_out + (size_t)s * D * D, D, D, WSP(bf16_t, WS_AWOUT) + (size_t)s * D * D, 0, scr, gw, NGW, lane, base);
        transpose_matrix(ap->in[16], D, 6144, WSP(bf16_t, WS_BWQKV), 0, scr, gw, NGW, lane, base);
        transpose_matrix(ap->in[22], D, D, WSP(bf16_t, WS_BWOUT), 0, scr, gw, NGW, lane, base);
        transpose_matrix(ap->in[23], D, D, WSP(bf16_t, WS_CWOUT), 0, scr, gw, NGW, lane, base);
        for (int l = 0; l < NLAYER; ++l) {
            transpose_matrix(ap->in[24] + (size_t)l * D * 512, D, 512, WSP(bf16_t, WS_XWQ) + (size_t)l * 512 * D, 0, scr, gw, NGW, lane, base);
            transpose_matrix(ap->in[25] + (size_t)l * D * 1024, D, 1024, WSP(bf16_t, WS_XWKV) + (size_t)l * 1024 * D, 0, scr, gw, NGW, lane, base);
            transpose_matrix(ap->in[26] + (size_t)l * 512 * D, 512, D, WSP(bf16_t, WS_XWOUT) + (size_t)l * D * 512, 0, scr, gw, NGW, lane, base);
        }
        convert_ffn_weights(ap->in[7], ap->in[8], ap->in[9], WSP(bf16_t, WS_W1), WSP(bf16_t, WS_WD), scr, gw, NGW, lane);
        rowpass<true, false, true>(ap->in[0], ap->in[1], ap->out, nullptr, WSP(bf16_t, WS_H), nullptr, ap->in[4], 1.f, gw, NGW, lane);
        { const float* mem_prompt = ap->in[2]; const float* mem_sample = ap->in[3]; const float* ln_mem = ap->in[6]; bf16_t* MEMN = WSP(bf16_t, WS_MEMN);
        for (int idx = gw; idx < NLAYER * NMEMTOK; idx += NGW) { const int l = idx / NMEMTOK, r = idx % NMEMTOK;
            const float* src = r < 256 ? mem_prompt + (size_t)r * D : mem_sample + (size_t)(r - 256) * D;
            const GAS f32x4* xr = (const GAS f32x4*)src + lane; f32x4 x[8]; float s2 = 0.f;
#pragma unroll
            for (int j = 0; j < 8; ++j) { x[j] = xr[64 * j]; s2 += (x[j].x * x[j].x + x[j].y * x[j].y) + (x[j].z * x[j].z + x[j].w * x[j].w); }
            const float r2 = rsqrtf(wave_sum(s2, lane) * (1.0f / D) + 1e-6f);
            GAS u32x2* ho = (GAS u32x2*)(MEMN + ((size_t)l * NMEMTOK + r) * D) + lane;
#pragma unroll
            for (int j = 0; j < 8; ++j) { const f32x4 g = *(const f32x4*)(ln_mem + l * D + 256 * j + 4 * lane); const f32x4 v = x[j] * r2 * g; u32x2 w; w.x = cvt_pk_bf16(v.x, v.y); w.y = cvt_pk_bf16(v.z, v.w); ho[64 * j] = w; } } }
        { float* ropeC = WSP(float, WS_ROPE_COS); float* ropeS = WSP(float, WS_ROPE_SIN); bf16_t* csT = WSP(bf16_t, WS_CS); bf16_t* wspT = WSP(bf16_t, WS_WSP); const float* a_w_s = ap->in[13];
        const int gt = vcu * NTHREADS + tid, NGT = G * NTHREADS;
        for (int idx = gt; idx < 8192 * 16; idx += NGT) { const int pos = idx >> 4, j = idx & 15;
            const float invf = (float)exp(-13.122363377404328 * (double)j * 0.0625);
            const float ang = (float)pos * invf; double s, c; sincos_d((double)ang, s, c); ropeC[idx] = (float)c; ropeS[idx] = (float)s; }
        for (int idx = gt; idx < 512 * 256; idx += NGT) { const int lp = idx >> 8, cch = idx & 255, l = lp & 255; const float fr = (float)((l * cch) & 255) * (1.0f / 256.0f);
            csT[idx] = (bf16_t)f2bf(lp < 256 ? __builtin_amdgcn_cosf(fr) : __builtin_amdgcn_sinf(fr)); }
        for (int idx = gt; idx < 2 * 8 * 128 * 128; idx += NGT) wspT[idx] = (bf16_t)f2bf(a_w_s[idx]); }
    PH_END

    PH_BEGIN
        pg8::BatchOrder S; S.nM = 9; S.nN = 4; S.nZ = NLAYER; S.G = G; S.c = bx; S.ldc = 1024;
        S.sAm = (size_t)256 * D; S.sAz = (size_t)NMEMTOK * D; S.sBn = (size_t)256 * D; S.sBz = (size_t)1024 * D; S.sCm = (size_t)256 * 1024; S.sCn = 256; S.sCz = (size_t)NMEMTOK * 1024;
        pg8::EpiBf16<0> E{WSP(bf16_t, WS_KV), 1.f};
        pg8::gemm_phase(tid, lds, WSP(bf16_t, WS_MEMN), WSP(bf16_t, WS_XWKV), D, D, D / 64, S, E);
    PH_END

    for (int hl = 0; hl < 2 * NLAYER; ++hl) {
        const int layer = hl >> 1, which = hl & 1;
        PH_BEGIN
            pg8::StdOrder S; S.init(NTOK, 2 * DFF, D, D, DFF, G, bx);
            pg8::EpiSwiGLU E{WSP(bf16_t, WS_A)};
            pg8::gemm_phase(tid, lds, WSP(bf16_t, WS_H), WSP(bf16_t, WS_W1), D, D, D / 64, S, E);
        PH_END
        PH_BEGIN
            pg8::StdOrder S; S.init(NTOK, D, DFF, DFF, D, G, bx);
            pg8::EpiBf16<0> E{WSP(bf16_t, WS_H), 1.f};
            pg8::gemm_phase(tid, lds, WSP(bf16_t, WS_A), WSP(bf16_t, WS_WD), DFF, DFF, DFF / 64, S, E);
        PH_END
        PH_BEGIN
            const float* ln_pre = ap->in[4]; const float* ln_post = ap->in[5]; bf16_t* RH = WSP(bf16_t, WS_H);
            const float* gpost = ln_post + (size_t)(layer * 4 + (which ? 3 : 0)) * D;
            if (hl == 2 * NLAYER - 1) rowpass<false, true, false>(nullptr, nullptr, ap->out, RH, nullptr, gpost, nullptr, 0.5f, gw, NGW, lane);
            else { const float* gpre = which ? ln_pre + (size_t)((layer + 1) * 4 + 0) * D : ln_pre + (size_t)(layer * 4 + 1) * D;
                rowpass<false, true, true>(nullptr, nullptr, ap->out, RH, RH, gpost, gpre, 0.5f, gw, NGW, lane);
                const size_t wo = (size_t)(hl + 1) * D * DFF;
                convert_ffn_weights(ap->in[7] + wo, ap->in[8] + wo, ap->in[9] + wo, WSP(bf16_t, WS_W1), WSP(bf16_t, WS_WD), (LAS float*)(lds + wave * 16384), gw, NGW, lane); }
        PH_END
        if (which == 0) {
            const int kind = layer % 3, slot = layer / 3;
            if (kind == 0) {
                PH_BEGIN
                    pg8::StdOrder S; S.init(NTOK, 4096, D, D, 4096, G, bx);
                    pg8::EpiBf16<1> E{WSP(bf16_t, WS_A), 1.f};
                    pg8::gemm_phase(tid, lds, WSP(bf16_t, WS_H), WSP(bf16_t, WS_AWIN) + (size_t)slot * 4096 * D, D, D, D / 64, S, E);
                PH_END
                PH_BEGIN
                    const bf16_t* RA = WSP(bf16_t, WS_A); f32x2* vstats = WSP(f32x2, WS_STATS);
                    for (int row = gw; row < NTOK; row += NGW) {
                        const GAS u32x4* vr = (const GAS u32x4*)(RA + (size_t)row * 4096 + 2048) + lane; u32x4 v[4]; float s = 0.f;
#pragma unroll
                        for (int j = 0; j < 4; ++j) { v[j] = vr[64 * j]; s += (bf_lo(v[j].x) + bf_hi(v[j].x)) + (bf_lo(v[j].y) + bf_hi(v[j].y)) + (bf_lo(v[j].z) + bf_hi(v[j].z)) + (bf_lo(v[j].w) + bf_hi(v[j].w)); }
                        const float mean = wave_sum(s, lane) * (1.0f / 2048.0f); float q = 0.f;
#pragma unroll
                        for (int j = 0; j < 4; ++j) { const unsigned w4[4] = {v[j].x, v[j].y, v[j].z, v[j].w};
#pragma unroll
                            for (int k = 0; k < 4; ++k) { const float a = bf_lo(w4[k]) - mean, b = bf_hi(w4[k]) - mean; q += a * a + b * b; } }
                        const float rstd = rsqrtf(wave_sum(q, lane) * (1.0f / 2048.0f) + 1e-5f);
                        if (lane == 0) vstats[row] = (f32x2){mean, rstd};
                    }
                PH_END
                PH_BEGIN
                    using namespace att;
                    const bf16_t* RA = WSP(bf16_t, WS_A); bf16_t* RH = WSP(bf16_t, WS_H); const f32x2* vstats = WSP(f32x2, WS_STATS); const bf16_t* wspT = WSP(bf16_t, WS_WSP);
                    const float* a_b_s = ap->in[14];
                    const int r32 = lane & 31, hi2 = lane >> 5, pb = wave & 3, ch = wave >> 2;
                    const int sr = tid >> 4, sc = (tid & 15) * 8, vst0 = v_st(sr, sc), vst1 = v_st(32 + sr, sc);
                    const int vb0 = (int)(uintptr_t)(lds_raw) + v_rd_base(lane);
                    const float* lng = ap->in[11] + (size_t)slot * 2048; const float* lnb = ap->in[12] + (size_t)slot * 2048;
                    for (int un = vcu; un < 320 * 8; un += G) {
                        const int g = un & 7, ck = un >> 3; const int tok0 = ck * 128;
                        __syncthreads();
#pragma unroll
                        for (int hc = 0; hc < 2; ++hc) {
                            const int gc = g * 256 + hc * 128 + sc;
                            const f32x4 g0 = *(const f32x4*)(lng + gc), g1 = *(const f32x4*)(lng + gc + 4), b0 = *(const f32x4*)(lnb + gc), b1 = *(const f32x4*)(lnb + gc + 4);
#pragma unroll
                            for (int kt = 0; kt < 2; ++kt)
#pragma unroll
                                for (int rr = 0; rr < 2; ++rr) { const int q = kt * 64 + rr * 32 + sr; const int tok = tok0 + q;
                                    const u32x4 raw = *(const GAS u32x4*)(RA + (size_t)tok * 4096 + 2048 + gc); const f32x2 st = vstats[tok];
                                    f32x4 a = (f32x4){bf_lo(raw.x), bf_hi(raw.x), bf_lo(raw.y), bf_hi(raw.y)}, b = (f32x4){bf_lo(raw.z), bf_hi(raw.z), bf_lo(raw.w), bf_hi(raw.w)};
                                    a = (a - st.x) * st.y * g0 + b0; b = (b - st.x) * st.y * g1 + b1;
                                    u32x4 w; w.x = cvt_pk_bf16(a.x, a.y); w.y = cvt_pk_bf16(a.z, a.w); w.z = cvt_pk_bf16(b.x, b.y); w.w = cvt_pk_bf16(b.z, b.w);
                                    *(LAS u32x4*)(lds + (kt * 2 + hc) * 16384 + (rr ? vst1 : vst0)) = w; }
                        }
                        bf16x8 pa[2][4];
                        const bf16_t* wrow = wspT + ((size_t)(slot * 8 + g) * 128 + 32 * pb + r32) * 128 + 8 * hi2;
#pragma unroll
                        for (int kt = 0; kt < 2; ++kt)
#pragma unroll
                            for (int i = 0; i < 4; ++i) pa[kt][i] = *(const bf16x8*)(wrow + kt * 64 + 16 * i);
                        __syncthreads();
                        f32x16 o[4] = {};
                        pv_d0(o, vb0 + (0 * 2 + ch) * 16384, pa[0][0], pa[0][1], pa[0][2], pa[0][3]);
                        pv_d0(o, vb0 + (1 * 2 + ch) * 16384, pa[1][0], pa[1][1], pa[1][2], pa[1][3]);
#pragma unroll
                        for (int r = 0; r < 16; ++r) { const int p = 32 * pb + crow(r, hi2); const int tok = tok0 + p; const float bias = a_b_s[(size_t)(slot * 8 + g) * 128 + p];
#pragma unroll
                            for (int d0 = 0; d0 < 4; ++d0) { const int c = g * 256 + ch * 128 + d0 * 32 + r32;
                                const float uu = bf_lo((unsigned)RA[(size_t)tok * 4096 + c]);
                                RH[(size_t)tok * D + c] = (bf16_t)f2bf(uu * (o[d0][r] + bias)); } }
                    }
                    __syncthreads();
                PH_END
            } else if (kind == 1) {
                PH_BEGIN
                    pg8::StdOrder S; S.init(NTOK, 6144, D, D, 6144, G, bx);
                    pg8::EpiBf16<0> E{WSP(bf16_t, WS_A), 1.f};
                    pg8::gemm_phase(tid, lds, WSP(bf16_t, WS_H), WSP(bf16_t, WS_BWQKV), D, D, D / 64, S, E);
                PH_END
                PH_BEGIN
                    bf16_t* RA = WSP(bf16_t, WS_A); const float* ropeC = WSP(float, WS_ROPE_COS); const float* ropeS = WSP(float, WS_ROPE_SIN);
                    const int v = lane >> 1, half = lane & 1;
                    const int colbase = (v < 16 ? v * 128 : 2048 + (v - 16) * 128) + 8 * half;
                    for (int row = gw; row < NTOK; row += NGW) {
                        const int pos = row < NPROMPT ? row : (row & (SSAMP - 1));
                        GAS u32x4* p1 = (GAS u32x4*)(RA + (size_t)row * 6144 + colbase); GAS u32x4* p2 = (GAS u32x4*)(RA + (size_t)row * 6144 + colbase + 16);
                        const u32x4 a = *p1, b = *p2;
                        const f32x4 c0 = *(const f32x4*)(ropeC + pos * 16 + 8 * half), c1 = *(const f32x4*)(ropeC + pos * 16 + 8 * half + 4), s0 = *(const f32x4*)(ropeS + pos * 16 + 8 * half), s1 = *(const f32x4*)(ropeS + pos * 16 + 8 * half + 4);
                        const float x1[8] = {bf_lo(a.x), bf_hi(a.x), bf_lo(a.y), bf_hi(a.y), bf_lo(a.z), bf_hi(a.z), bf_lo(a.w), bf_hi(a.w)};
                        const float x2[8] = {bf_lo(b.x), bf_hi(b.x), bf_lo(b.y), bf_hi(b.y), bf_lo(b.z), bf_hi(b.z), bf_lo(b.w), bf_hi(b.w)};
                        const float cc[8] = {c0.x, c0.y, c0.z, c0.w, c1.x, c1.y, c1.z, c1.w}, sn[8] = {s0.x, s0.y, s0.z, s0.w, s1.x, s1.y, s1.z, s1.w};
                        float o1[8], o2[8];
#pragma unroll
                        for (int j = 0; j < 8; ++j) { o1[j] = x1[j] * cc[j] - x2[j] * sn[j]; o2[j] = x2[j] * cc[j] + x1[j] * sn[j]; }
                        *p1 = (u32x4){cvt_pk_bf16(o1[0], o1[1]), cvt_pk_bf16(o1[2], o1[3]), cvt_pk_bf16(o1[4], o1[5]), cvt_pk_bf16(o1[6], o1[7])};
                        *p2 = (u32x4){cvt_pk_bf16(o2[0], o2[1]), cvt_pk_bf16(o2[2], o2[3]), cvt_pk_bf16(o2[4], o2[5]), cvt_pk_bf16(o2[6], o2[7])};
                    }
                PH_END
                PH_BEGIN
                    const bf16_t* RA = WSP(bf16_t, WS_A); bf16_t* RB = WSP(bf16_t, WS_B);
                    for (int idx = vcu; idx < 5120; idx += G) {
                        int h16, vh, qb, seq; size_t t0;
                        if (idx < 1024) { const int i = idx >> 8, w = idx & 255; const int combo = (w >> 5) * 4 + i; qb = w & 31; h16 = combo >> 1; vh = combo & 1; t0 = 0; seq = NPROMPT; }
                        else { const int id2 = idx - 1024; h16 = id2 >> 8; const int w = id2 & 255; const int b = w >> 5, jj = w & 31; vh = jj >> 4; qb = jj & 15; t0 = (size_t)NPROMPT + (size_t)b * SSAMP; seq = SSAMP; }
                        const bf16_t* Q = RA + (t0 + qb * 256) * 6144 + h16 * 128; const bf16_t* K = RA + t0 * 6144 + 2048 + h16 * 128; const bf16_t* V = RA + t0 * 6144 + 4096 + (h16 >> 1) * 256 + vh * 128;
                        bf16_t* O = RB + (size_t)(h16 & 1) * NTOK * D + (t0 + qb * 256) * D + (h16 >> 1) * 256 + vh * 128;
                        const int tid2 = wave * 64 + lane_id_asm();
                        att::attn_dense_body<6144, 6144, 2048>(tid2, Q, K, V, O, seq, (char*)lds_raw); __syncthreads(); }
                PH_END
                PH_BEGIN
                    const float* b_lq1 = ap->in[17]; const float* b_lk1 = ap->in[18]; const float* b_lq2 = ap->in[19]; const float* b_lk2 = ap->in[20]; const float* b_subln = ap->in[21];
                    const float lam_init = 0.8f - 0.6f * expf(-0.3f * (float)layer);
                    float d1 = b_lq1[lane] * b_lk1[lane] + b_lq1[lane + 64] * b_lk1[lane + 64], d2 = b_lq2[lane] * b_lk2[lane] + b_lq2[lane + 64] * b_lk2[lane + 64];
                    const float lam = expf(wave_sum(d1, lane)) - expf(wave_sum(d2, lane)) + lam_init;
                    const f32x4 sg = *(const f32x4*)(b_subln + 4 * lane); const float osc = 1.0f - lam_init;
                    const bf16_t* O0 = WSP(bf16_t, WS_B); const bf16_t* O1 = O0 + (size_t)NTOK * D; bf16_t* RH = WSP(bf16_t, WS_H);
                    for (int row = gw; row < NTOK; row += NGW) {
                        const GAS u32x2* p0 = (const GAS u32x2*)(O0 + (size_t)row * D) + lane; const GAS u32x2* p1 = (const GAS u32x2*)(O1 + (size_t)row * D) + lane;
                        GAS u32x2* po = (GAS u32x2*)(RH + (size_t)row * D) + lane;
                        u32x2 a[8], b[8];
#pragma unroll
                        for (int j = 0; j < 8; ++j) { a[j] = p0[64 * j]; b[j] = p1[64 * j]; }
#pragma unroll
                        for (int j = 0; j < 8; ++j) { f32x4 dv = (f32x4){bf_lo(a[j].x) - lam * bf_lo(b[j].x), bf_hi(a[j].x) - lam * bf_hi(b[j].x), bf_lo(a[j].y) - lam * bf_lo(b[j].y), bf_hi(a[j].y) - lam * bf_hi(b[j].y)};
                            const float ss = wave_sum((dv.x * dv.x + dv.y * dv.y) + (dv.z * dv.z + dv.w * dv.w), lane); const float r = rsqrtf(ss * (1.0f / 256.0f) + 1e-5f) * osc;
                            dv = dv * r * sg; u32x2 w; w.x = cvt_pk_bf16(dv.x, dv.y); w.y = cvt_pk_bf16(dv.z, dv.w); po[64 * j] = w; }
                    }
                PH_END
            } else {
                PH_BEGIN
                    {
                        bf16_t* Tp = WSP(bf16_t, WS_B); bf16_t* Ts = Tp + (size_t)8192 * 16384;
                        const long gt = (long)vcu * NTHREADS + tid, NGT = (long)G * NTHREADS;
                        for (long it = gt; it < (long)8192 * 2048; it += NGT) { const int k = (int)(it >> 11), c8 = (int)(it & 2047), part = c8 >> 10, s0 = (c8 & 1023) * 8; unsigned w[4];
#pragma unroll
                            for (int e = 0; e < 4; ++e) { const float f0 = (float)((k * (s0 + 2 * e)) & 8191) * (1.0f / 8192.0f), f1 = (float)((k * (s0 + 2 * e + 1)) & 8191) * (1.0f / 8192.0f);
                                const float v0 = part ? -__builtin_amdgcn_sinf(f0) : __builtin_amdgcn_cosf(f0), v1 = part ? -__builtin_amdgcn_sinf(f1) : __builtin_amdgcn_cosf(f1); w[e] = cvt_pk_bf16(v0, v1); }
                            *(GAS u32x4*)(Tp + (size_t)k * 16384 + part * 8192 + s0) = (u32x4){w[0], w[1], w[2], w[3]}; }
                        for (long it = gt; it < (long)4096 * 1024; it += NGT) { const int k = (int)(it >> 10), c8 = (int)(it & 1023), part = c8 >> 9, s0 = (c8 & 511) * 8; unsigned w[4];
#pragma unroll
                            for (int e = 0; e < 4; ++e) { const float f0 = (float)((k * (s0 + 2 * e)) & 4095) * (1.0f / 4096.0f), f1 = (float)((k * (s0 + 2 * e + 1)) & 4095) * (1.0f / 4096.0f);
                                const float v0 = part ? -__builtin_amdgcn_sinf(f0) : __builtin_amdgcn_cosf(f0), v1 = part ? -__builtin_amdgcn_sinf(f1) : __builtin_amdgcn_cosf(f1); w[e] = cvt_pk_bf16(v0, v1); }
                            *(GAS u32x4*)(Ts + (size_t)k * 8192 + part * 4096 + s0) = (u32x4){w[0], w[1], w[2], w[3]}; }
                    }
                    pg8::F1Order S; S.G = G; S.c = bx;
                    pg8::EpiBf16<0> E{WSP(bf16_t, WS_A), 1.f};
                    pg8::gemm_phase(tid, lds, WSP(bf16_t, WS_CS), WSP(bf16_t, WS_H), 256, D, 4, S, E);
                PH_END
                PH_BEGIN
                    {   pg8::StdOrder S; S.init(NPROMPT, D, 16384, 16384, D, G, bx);
                        pg8::EpiBf16<0> E{WSP(bf16_t, WS_H), 6.9053396600248786e-04f};
                        pg8::gemm_phase(tid, lds, WSP(bf16_t, WS_B), WSP(bf16_t, WS_A), 16384, 16384, 256, S, E); }
                    {   pg8::BatchOrder S; S.nM = 16; S.nN = 8; S.nZ = 8; S.G = G; S.c = bx; S.ldc = D;
                        S.sAm = (size_t)256 * 8192; S.sAz = 0; S.sBn = (size_t)256 * 8192; S.sBz = (size_t)2048 * 8192; S.sCm = (size_t)256 * D; S.sCn = 256; S.sCz = (size_t)SSAMP * D;
                        pg8::EpiBf16<0> E{WSP(bf16_t, WS_H) + (size_t)NPROMPT * D, 9.765625e-04f};
                        pg8::gemm_phase(tid, lds, WSP(bf16_t, WS_B) + (size_t)8192 * 16384, WSP(bf16_t, WS_A) + (size_t)2048 * 16384, 8192, 8192, 128, S, E); }
                PH_END
            }
            PH_BEGIN
                const bf16_t* WOT = kind == 0 ? WSP(bf16_t, WS_AWOUT) + (size_t)slot * D * D : (kind == 1 ? WSP(bf16_t, WS_BWOUT) : WSP(bf16_t, WS_CWOUT));
                pg8::StdOrder S; S.init(NTOK, D, D, D, D, G, bx);
                pg8::EpiBf16<0> E{WSP(bf16_t, WS_A), 1.f};
                pg8::gemm_phase(tid, lds, WSP(bf16_t, WS_H), WOT, D, D, D / 64, S, E);
            PH_END
            PH_BEGIN
                rowpass<false, true, true>(nullptr, nullptr, ap->out, WSP(bf16_t, WS_A), WSP(bf16_t, WS_H), ap->in[5] + (size_t)(layer * 4 + 1) * D, ap->in[4] + (size_t)(layer * 4 + 2) * D, 1.0f, gw, NGW, lane);
            PH_END
            PH_BEGIN
                pg8::StdOrder S; S.init(NTOK, 512, D, D, 512, G, bx);
                pg8::EpiBf16<0> E{WSP(bf16_t, WS_A), 1.f};
                pg8::gemm_phase(tid, lds, WSP(bf16_t, WS_H), WSP(bf16_t, WS_XWQ) + (size_t)layer * 512 * D, D, D, D / 64, S, E);
            PH_END
            PH_BEGIN
                const bf16_t* QX = WSP(bf16_t, WS_A); bf16_t* OX = WSP(bf16_t, WS_A) + (size_t)NTOK * 512;
                const bf16_t* KVl = WSP(bf16_t, WS_KV) + (size_t)layer * NMEMTOK * 1024;
                for (int idx = vcu; idx < 640; idx += G) { const int tb = idx >> 2, head = idx & 3; const int bm = tb < 32 ? 0 : 1 + ((tb - 32) >> 4);
                    const bf16_t* Q = QX + (size_t)tb * 256 * 512 + head * 128; const bf16_t* K = KVl + (size_t)bm * 256 * 1024 + head * 128; const bf16_t* V = K + 512;
                    bf16_t* O = OX + (size_t)tb * 256 * 512 + head * 128;
                    const int tid2 = wave * 64 + lane_id_asm();
                    att::attn_dense_body<512, 1024, 512>(tid2, Q, K, V, O, 256, (char*)lds_raw); __syncthreads(); }
            PH_END
            PH_BEGIN
                pg8::StdOrder S; S.init(NTOK, D, 512, 512, D, G, bx);
                pg8::EpiBf16<0> E{WSP(bf16_t, WS_A) + (size_t)NTOK * 1024, 1.f};
                pg8::gemm_phase(tid, lds, WSP(bf16_t, WS_A) + (size_t)NTOK * 512, WSP(bf16_t, WS_XWOUT) + (size_t)layer * D * 512, 512, 512, 8, S, E);
            PH_END
            PH_BEGIN
                rowpass<false, true, true>(nullptr, nullptr, ap->out, WSP(bf16_t, WS_A) + (size_t)NTOK * 1024, WSP(bf16_t, WS_H), ap->in[5] + (size_t)(layer * 4 + 2) * D, ap->in[4] + (size_t)(layer * 4 + 3) * D, 1.0f, gw, NGW, lane);
            PH_END
        }
    }
#undef PH_BEGIN
#undef PH_END
#undef WSP
}

extern "C" void kernel_launch(void* const* d_in, const int* in_sizes, int n_in, void* d_out, int out_size, void* d_ws, size_t ws_size, hipStream_t stream) {
    static int grid = 0;
    if (grid == 0) {
        if (n_in != 27 || out_size != NTOK * D || ws_size < WS_END) { fprintf(stderr, "kernel_launch: unexpected shapes: n_in %d out %d ws %zu (need %zu)\n", n_in, out_size, ws_size, (size_t)WS_END); grid = -1; return; }
        int dev = 0, cus = 0, per_cu = 0;
        if (hipGetDevice(&dev) != hipSuccess || hipDeviceGetAttribute(&cus, hipDeviceAttributeMultiprocessorCount, dev) != hipSuccess) { grid = -1; return; }
        if (hipFuncSetAttribute((const void*)trunk_fwd, hipFuncAttributeMaxDynamicSharedMemorySize, LDS_BYTES) != hipSuccess) { fprintf(stderr, "kernel_launch: hipFuncSetAttribute failed\n"); grid = -1; return; }
        if (hipOccupancyMaxActiveBlocksPerMultiprocessor(&per_cu, (const void*)trunk_fwd, NTHREADS, LDS_BYTES) != hipSuccess || per_cu < 1) fprintf(stderr, "kernel_launch: occupancy query reports %d\n", per_cu);
        (void)hipGetLastError();
        grid = cus;
    }
    if (grid < 0) return;
    (void)hipMemsetAsync((char*)d_ws + WS_CTL, 0, CTL_ZERO_BYTES, stream);
    Args a{};
    for (int i = 0; i < 27; ++i) a.in[i] = (const float*)d_in[i];
    a.out = (float*)d_out; a.ws = (unsigned char*)d_ws;
    constexpr int NPH = total_phases();
#if MK_PER_PHASE
    for (int p = 0; p < NPH; ++p) { a.ph_lo = p; a.ph_hi = p + 1; hipLaunchKernelGGL(trunk_fwd, dim3(grid), dim3(NTHREADS), LDS_BYTES, stream, a); }
#else
    a.ph_lo = 0; a.ph_hi = NPH; hipLaunchKernelGGL(trunk_fwd, dim3(grid), dim3(NTHREADS), LDS_BYTES, stream, a);
#endif
    const hipError_t le = hipPeekAtLastError();
    if (le != hipSuccess) fprintf(stderr, "kernel_launch: launch failed: %s\n", hipGetErrorName(le));
}
```

```cpp
#include <hip/hip_runtime.h>
#include <cstdio>
#include <cstdint>

#ifndef PROBE_ID
#define PROBE_ID 0
#endif
#define PREP(k) for (int rep_ = 0; rep_ < ((PROBE_ID == (k)) ? 2 : 1); ++rep_)
#ifndef MK_PER_PHASE
#define MK_PER_PHASE 0
#endif

#define LAS __attribute__((address_space(3)))
#define GAS __attribute__((address_space(1)))
typedef unsigned short bf16_t;
typedef short bf16x8 __attribute__((ext_vector_type(8)));
typedef short s16x4 __attribute__((ext_vector_type(4)));
typedef float f32x2 __attribute__((ext_vector_type(2)));
typedef float f32x4 __attribute__((ext_vector_type(4)));
typedef float f32x16 __attribute__((ext_vector_type(16)));
typedef unsigned u32x2 __attribute__((ext_vector_type(2)));
typedef unsigned u32x4 __attribute__((ext_vector_type(4)));

constexpr int D = 2048, NTOK = 40960, NPROMPT = 8192, SSAMP = 4096, DFF = 5504, NMEMTOK = 2304, NLAYER = 4;
constexpr int NWAVES = 8, NTHREADS = 512;

constexpr size_t MiB = 1u << 20;
constexpr size_t WS_CTL = 0, CTL_ZERO_BYTES = 1 * MiB;
constexpr size_t WS_ROPE_COS = 1 * MiB, WS_ROPE_SIN = WS_ROPE_COS + 512 * 1024;
constexpr size_t WS_WSP = 2 * MiB;
constexpr size_t WS_STATS = 2 * MiB + 512 * 1024;
constexpr size_t WS_RSTD = 3 * MiB;
constexpr size_t WS_KV = 4 * MiB;
constexpr size_t WS_MEMN = 22 * MiB;
constexpr size_t WS_AWIN = 58 * MiB;
constexpr size_t WS_AWOUT = 90 * MiB;
constexpr size_t WS_BWQKV = 106 * MiB;
constexpr size_t WS_BWOUT = 130 * MiB;
constexpr size_t WS_CWOUT = 138 * MiB;
constexpr size_t WS_XWQ = 146 * MiB;
constexpr size_t WS_XWKV = 154 * MiB;
constexpr size_t WS_XWOUT = 170 * MiB;
constexpr size_t WS_W1 = 178 * MiB;
constexpr size_t WS_WD = 221 * MiB;
constexpr size_t WS_H = 244 * MiB;
constexpr size_t WS_A = 404 * MiB;
constexpr size_t WS_B = 884 * MiB;
constexpr size_t WS_CS = 1204 * MiB;
constexpr size_t WS_END = 1206 * MiB;
constexpr int CW_BAR = 4096;

constexpr int RING_BYTES = 131072;
constexpr int MISC_OFF = RING_BYTES + 320;
constexpr int LDS_BYTES = 147456;

__device__ __forceinline__ unsigned f2bf(float f) { unsigned u = __builtin_bit_cast(unsigned, f); return (u + 0x7fffu + ((u >> 16) & 1u)) >> 16; }
__device__ __forceinline__ unsigned cvt_pk_bf16(float lo, float hi) { unsigned r; asm volatile("v_cvt_pk_bf16_f32 %0, %1, %2" : "=v"(r) : "v"(lo), "v"(hi)); return r; }
__device__ __forceinline__ float bf_lo(unsigned w) { return __builtin_bit_cast(float, w << 16); }
__device__ __forceinline__ float bf_hi(unsigned w) { return __builtin_bit_cast(float, w & 0xffff0000u); }
__device__ __forceinline__ float wave_sum(float v, int lane) {
#pragma unroll
    for (int o = 1; o < 64; o <<= 1) v += __builtin_bit_cast(float, __builtin_amdgcn_ds_bpermute((lane ^ o) << 2, __builtin_bit_cast(int, v)));
    return v;
}
__device__ __forceinline__ int lane_id_asm() { int l; asm volatile("v_mbcnt_lo_u32_b32 %0, -1, 0\n\tv_mbcnt_hi_u32_b32 %0, -1, %0" : "=v"(l)); return l; }
#define LDS_WAIT() asm volatile("s_waitcnt lgkmcnt(0)" ::: "memory")
#define VM_WAIT() asm volatile("s_waitcnt vmcnt(0)" ::: "memory")

namespace pg8 {
constexpr int BM = 256, BK = 64, HALF = 128, HTB = HALF * BK * 2, STAGE_BYTES = 8 * HTB, NXCD = 8, WGM = 8;
__host__ __device__ __forceinline__ int lds_byte(int r, int c) { const int st = (r >> 4) * 2 + (c >> 5), rr = r & 15, cc = c & 31, ob = rr * 64 + cc * 2; return st * 1024 + (ob ^ (((ob >> 9) & 1) << 5)); }
__host__ __device__ __forceinline__ void stage_rc(int b, int& R, int& C) { const int st = b / 1024, sb = b % 1024, swz = sb ^ (((sb >> 9) & 1) << 5); R = (st >> 1) * 16 + swz / 64; C = (st & 1) * 32 + (swz % 64) / 2; }
__host__ __device__ __forceinline__ int perm32(int rho) { const int n = rho >> 4, i = rho & 15; return 8 * (i >> 2) + 4 * n + (i & 3); }

struct Unit { int pm, pn, z, ldc; size_t offA, offB, offC; };

struct StdOrder {
    int nM, nN, nwg, G, c, ldc; size_t sA, sB, sCm, sCn;
    __device__ void init(int M, int N, int lda, int ldb, int ldc_, int G_, int c_, int cn = 256) { nM = M / BM; nN = N / BM; nwg = nM * nN; G = G_; c = c_; ldc = ldc_; sA = (size_t)BM * lda; sB = (size_t)BM * ldb; sCm = (size_t)BM * ldc_; sCn = (size_t)cn; }
    __device__ __forceinline__ bool next(int i, Unit& u) const {
        const long L = (long)i * G + c; if (L >= nwg) return false;
        int wgid = (int)L; { const int q = nwg / NXCD, r = nwg % NXCD, xcd = wgid % NXCD, off = wgid / NXCD; wgid = (xcd < r ? xcd * (q + 1) : r * (q + 1) + (xcd - r) * q) + off; }
        const int nig = WGM * nN, gid = wgid / nig, fm = gid * WGM, gsz = (nM - fm) < WGM ? (nM - fm) : WGM;
        u.pm = fm + ((wgid % nig) % gsz); u.pn = (wgid % nig) / gsz; u.z = 0; u.ldc = ldc;
        u.offA = (size_t)u.pm * sA; u.offB = (size_t)u.pn * sB; u.offC = (size_t)u.pm * sCm + (size_t)u.pn * sCn; return true;
    }
};
struct BatchOrder {
    int nM, nN, nZ, G, c, ldc; size_t sAm, sAz, sBn, sBz, sCm, sCn, sCz;
    __device__ __forceinline__ bool next(int i, Unit& u) const {
        const long L = (long)i * G + c; const int per = nM * nN; if (L >= (long)per * nZ) return false;
        const int z = (int)(L / per), r = (int)(L % per); u.z = z; u.pm = r % nM; u.pn = r / nM; u.ldc = ldc;
        u.offA = (size_t)u.pm * sAm + (size_t)z * sAz; u.offB = (size_t)u.pn * sBn + (size_t)z * sBz; u.offC = (size_t)u.pm * sCm + (size_t)u.pn * sCn + (size_t)z * sCz; return true;
    }
};
struct F1Order {
    int G, c;
    __device__ __forceinline__ bool next(int i, Unit& u) const {
        const long L = (long)i * G + c; if (L >= 2560) return false;
        const int g = (int)(L / 320), r = (int)(L % 320); u.z = g; u.pm = r & 1; u.pn = r >> 1;
        u.offA = (size_t)g * 512 * 256 + (size_t)u.pm * 256 * 256; u.offB = (size_t)u.pn * 256 * 2048 + (size_t)g * 256;
        if (u.pn < 32) { u.ldc = 16384; u.offC = (size_t)(g * 256) * 16384 + (size_t)u.pm * 8192 + (size_t)u.pn * 256; }
        else { const int rr = u.pn - 32, bb = rr >> 4, s0 = (rr & 15) * 256; u.ldc = 8192; u.offC = (size_t)2048 * 16384 + (size_t)bb * 2048 * 8192 + (size_t)(g * 256) * 8192 + (size_t)u.pm * 4096 + s0; }
        return true;
    }
};

__device__ __forceinline__ f32x2 gelu_pk(f32x2 v) {
    const f32x2 av = __builtin_elementwise_abs(v), d = av * 0.2316418882f + 1.0f;
    f32x2 t; t.x = __builtin_amdgcn_rcpf(d.x); t.y = __builtin_amdgcn_rcpf(d.y);
    f32x2 q = t * 0.5307027145f + (-0.7265760135f); q = q * t + 0.7107068705f; q = q * t + (-0.142248368f); q = q * t + 0.127414796f; q = q * t;
    const f32x2 s = (v * v) * (-0.72134752044f);
    f32x2 e; e.x = __builtin_amdgcn_exp2f(s.x); e.y = __builtin_amdgcn_exp2f(s.y);
    const f32x2 m = v * (q * e), r = v - m;
    f32x2 o; o.x = v.x < 0.f ? m.x : r.x; o.y = v.y < 0.f ? m.y : r.y; return o;
}
template <int ACT  , int SM = 0> struct EpiBf16 {
    bf16_t* O; float scale; const float* rs;
    __device__ __forceinline__ void operator()(const f32x4 (&acc)[2][2][4][2], const Unit& u, int wr, int wc, int fr, int fq) const {
        bf16_t* base = O + u.offC + (size_t)(wr * 64 + fr) * u.ldc + wc * 32 + 8 * fq;
        f32x4 cs0[2], cs1[2];
        if (SM == 2) {
#pragma unroll
            for (int bj = 0; bj < 2; ++bj) { const float* p = rs + u.pn * BM + bj * HALF + wc * 32 + 8 * fq; cs0[bj] = *(const f32x4*)p; cs1[bj] = *(const f32x4*)(p + 4); } }
#pragma unroll
        for (int ai = 0; ai < 2; ++ai)
#pragma unroll
            for (int m = 0; m < 4; ++m) { bf16_t* rowp = base + (size_t)(ai * HALF + m * 16) * u.ldc;
                float rsc = scale; if (SM == 1) rsc = rs[u.pm * BM + ai * HALF + wr * 64 + m * 16 + fr] * scale;
#pragma unroll
                for (int bj = 0; bj < 2; ++bj) { f32x4 v0 = acc[ai][bj][m][0] * rsc, v1 = acc[ai][bj][m][1] * rsc;
                    if (SM == 2) { v0 = v0 * cs0[bj]; v1 = v1 * cs1[bj]; }
                    if (ACT == 1) { f32x2 a = gelu_pk((f32x2){v0[0], v0[1]}), b = gelu_pk((f32x2){v0[2], v0[3]}), c = gelu_pk((f32x2){v1[0], v1[1]}), d = gelu_pk((f32x2){v1[2], v1[3]});
                        v0 = (f32x4){a.x, a.y, b.x, b.y}; v1 = (f32x4){c.x, c.y, d.x, d.y}; }
                    u32x4 w; w.x = cvt_pk_bf16(v0[0], v0[1]); w.y = cvt_pk_bf16(v0[2], v0[3]); w.z = cvt_pk_bf16(v1[0], v1[1]); w.w = cvt_pk_bf16(v1[2], v1[3]);
                    *(u32x4*)(rowp + bj * HALF) = w; } }
    }
};
struct EpiSwiGLU {
    bf16_t* O; const float* rs;
    __device__ __forceinline__ void operator()(const f32x4 (&acc)[2][2][4][2], const Unit& u, int wr, int wc, int fr, int fq) const {
        bf16_t* base = O + (size_t)(u.pm * BM + wr * 64 + fr) * DFF + u.pn * 128 + wc * 32 + 8 * fq;
#pragma unroll
        for (int ai = 0; ai < 2; ++ai)
#pragma unroll
            for (int m = 0; m < 4; ++m) { bf16_t* rowp = base + (size_t)(ai * HALF + m * 16) * DFF; float r[8];
                const float rsc = rs[u.pm * BM + ai * HALF + wr * 64 + m * 16 + fr];
#pragma unroll
                for (int n = 0; n < 2; ++n)
#pragma unroll
                    for (int j = 0; j < 4; ++j) { const float g = acc[ai][0][m][n][j] * rsc, up = acc[ai][1][m][n][j] * rsc;
                        const float sg = g * __builtin_amdgcn_rcpf(1.0f + __builtin_amdgcn_exp2f(-1.4426950408889634f * g)); r[n * 4 + j] = sg * up; }
                u32x4 w; w.x = cvt_pk_bf16(r[0], r[1]); w.y = cvt_pk_bf16(r[2], r[3]); w.z = cvt_pk_bf16(r[4], r[5]); w.w = cvt_pk_bf16(r[6], r[7]);
                *(u32x4*)rowp = w; }
    }
};

template <class Epi, class Sched>
__device__ __forceinline__ void gemm_phase(const int tid, LAS unsigned char* lds, const bf16_t* Abase, const bf16_t* Bbase, const int lda, const int ldb, const int nt, const Sched& S, const Epi& E) {
    const int wid = __builtin_amdgcn_readfirstlane(tid >> 6), lane = tid & 63, wr = wid >> 2, wc = wid & 3, fr = lane & 15, fq = lane >> 4;
    unsigned voffA[2], voffB[2];
#pragma unroll
    for (int i = 0; i < 2; ++i) { int R, C; stage_rc(tid * 16 + i * 8192, R, C); const int Rb = (R & ~31) + perm32(R & 31);
        voffA[i] = (unsigned)(R * lda + C) * 2u; voffB[i] = (unsigned)(Rb * ldb + C) * 2u; }
    const size_t kstep = (size_t)(BK * 2);
    const size_t hstepA = (size_t)HALF * lda * 2, hstepB = (size_t)HALF * ldb * 2;
    const unsigned ldsw = (unsigned)wid * 1024u;
    const int aoff = lds_byte(wr * 64 + fr, fq * 8), boff = lds_byte(wc * 32 + fr, fq * 8);
#define PG8_SA(b, h) (((b) * 2 + (h)) * HTB)
#define PG8_SB(b, h) ((4 + (b) * 2 + (h)) * HTB)
#define PG8_STAGE(bufoff, gbase, voff) do { _Pragma("unroll") for (int _i = 0; _i < 2; ++_i) \
        __builtin_amdgcn_global_load_lds((const unsigned*)((const char*)(gbase) + (voff)[_i]), (LAS unsigned*)(lds + (bufoff) + ldsw + _i * 8192), 16, 0, 0); } while (0)
#define PG8_LDA(dst, b, h) do { _Pragma("unroll") for (int m = 0; m < 4; ++m) _Pragma("unroll") for (int k = 0; k < 2; ++k) dst[m][k] = *(const LAS bf16x8*)(lds + PG8_SA(b, h) + aoff + m * 2048 + k * 1024); } while (0)
#define PG8_LDB(dst, b, h) do { _Pragma("unroll") for (int n = 0; n < 2; ++n) _Pragma("unroll") for (int k = 0; k < 2; ++k) dst[n][k] = *(const LAS bf16x8*)(lds + PG8_SB(b, h) + boff + n * 2048 + k * 1024); } while (0)
#define PG8_MMA(ai, bj, At, Bt) do { __builtin_amdgcn_s_setprio(1); _Pragma("unroll") for (int m = 0; m < 4; ++m) _Pragma("unroll") for (int n = 0; n < 2; ++n) _Pragma("unroll") for (int k = 0; k < 2; ++k) \
        acc[ai][bj][m][n] = __builtin_amdgcn_mfma_f32_16x16x32_bf16(Bt[n][k], At[m][k], acc[ai][bj][m][n], 0, 0, 0); __builtin_amdgcn_s_setprio(0); } while (0)
#define PG8_WAIT_V(n) asm volatile("s_waitcnt vmcnt(" #n ")" ::: "memory")
#define PG8_WAIT_L(n) asm volatile("s_waitcnt lgkmcnt(" #n ")" ::: "memory")
#define PG8_BAR __builtin_amdgcn_s_barrier()
#define PG8_SCHED __builtin_amdgcn_sched_barrier(0)
    Unit cur, nxt; int ui = 0;
    if (!S.next(0, cur)) return;
    f32x4 acc[2][2][4][2];
#pragma unroll
    for (int a = 0; a < 2; ++a)
#pragma unroll
        for (int b = 0; b < 2; ++b)
#pragma unroll
            for (int m = 0; m < 4; ++m)
#pragma unroll
                for (int n = 0; n < 2; ++n) acc[a][b][m][n] = (f32x4){0.f, 0.f, 0.f, 0.f};
    bf16x8 At[4][2], B0[2][2], B1[2][2];
    const char* cA = (const char*)(Abase + cur.offA); const char* cB = (const char*)(Bbase + cur.offB);
    PG8_STAGE(PG8_SB(0, 0), cB, voffB); PG8_STAGE(PG8_SB(0, 1), cB + hstepB, voffB); PG8_STAGE(PG8_SA(0, 0), cA, voffA); PG8_STAGE(PG8_SA(0, 1), cA + hstepA, voffA);
    if (wr == 1) PG8_BAR;
    PG8_WAIT_V(2); PG8_BAR;
    PG8_STAGE(PG8_SB(1, 0), cB + kstep, voffB); PG8_STAGE(PG8_SA(1, 0), cA + kstep, voffA); PG8_STAGE(PG8_SB(1, 1), cB + hstepB + kstep, voffB);
    PG8_WAIT_V(6); PG8_BAR;
    for (;;) {
        const bool has_next = S.next(ui + 1, nxt);
        const char* nA = has_next ? (const char*)(Abase + nxt.offA) : cA; const char* nB = has_next ? (const char*)(Bbase + nxt.offB) : cB;
        for (int t = 0; t < nt; t += 2) {
            const bool last = (t == nt - 2);
            const char* a1 = cA + (size_t)(t + 1) * kstep;
            const char* a2 = last ? nA : cA + (size_t)(t + 2) * kstep; const char* b2 = last ? nB : cB + (size_t)(t + 2) * kstep;
            const char* a3 = a2 + kstep; const char* b3 = b2 + kstep;
            PG8_LDB(B0, 0, 0); PG8_LDB(B1, 0, 1); PG8_SCHED; PG8_LDA(At, 0, 0); PG8_STAGE(PG8_SA(1, 1), a1 + hstepA, voffA);
            PG8_WAIT_V(8); PG8_WAIT_L(0); PG8_BAR; PG8_MMA(0, 0, At, B0); PG8_MMA(0, 1, At, B1); PG8_BAR; PG8_SCHED;
            PG8_LDA(At, 0, 1); PG8_STAGE(PG8_SB(0, 0), b2, voffB); PG8_STAGE(PG8_SB(0, 1), b2 + hstepB, voffB); PG8_STAGE(PG8_SA(0, 0), a2, voffA);
            PG8_WAIT_V(8); PG8_WAIT_L(0); PG8_BAR; PG8_MMA(1, 0, At, B0); PG8_MMA(1, 1, At, B1); PG8_BAR; PG8_SCHED;
            PG8_LDB(B0, 1, 0); PG8_LDB(B1, 1, 1); PG8_SCHED; PG8_LDA(At, 1, 0); PG8_STAGE(PG8_SA(0, 1), a2 + hstepA, voffA);
            PG8_WAIT_V(8); PG8_WAIT_L(0); PG8_BAR; PG8_MMA(0, 0, At, B0); PG8_MMA(0, 1, At, B1); PG8_BAR; PG8_SCHED;
            PG8_LDA(At, 1, 1); PG8_STAGE(PG8_SB(1, 0), b3, voffB); PG8_STAGE(PG8_SB(1, 1), b3 + hstepB, voffB); PG8_STAGE(PG8_SA(1, 0), a3, voffA);
            PG8_WAIT_V(8); PG8_WAIT_L(0); PG8_BAR; PG8_MMA(1, 0, At, B0); PG8_MMA(1, 1, At, B1); PG8_BAR; PG8_SCHED;
        }
        if (wr == 0) PG8_BAR;
        { const int ln2 = lane_id_asm(); E(acc, cur, wr, wc, ln2 & 15, ln2 >> 4); }
        if (!has_next) break;
#pragma unroll
        for (int a = 0; a < 2; ++a)
#pragma unroll
            for (int b = 0; b < 2; ++b)
#pragma unroll
                for (int m = 0; m < 4; ++m)
#pragma unroll
                    for (int n = 0; n < 2; ++n) acc[a][b][m][n] = (f32x4){0.f, 0.f, 0.f, 0.f};
        cur = nxt; cA = nA; cB = nB; ++ui;
        if (wr == 1) PG8_BAR;
    }
    PG8_WAIT_V(0);
    PG8_BAR;
#undef PG8_SA
#undef PG8_SB
#undef PG8_STAGE
#undef PG8_LDA
#undef PG8_LDB
#undef PG8_MMA
#undef PG8_WAIT_V
#undef PG8_WAIT_L
#undef PG8_BAR
#undef PG8_SCHED
}
}

namespace att {
constexpr int AD = 128, NW = 8, QBLK = 32, KVBLK = 64;
constexpr float SCALE = 0.088388347648318440f;
constexpr float THR = 8.f;
constexpr size_t SHM_V = KVBLK * AD * 2, SHM_K = KVBLK * AD * 2, SHM_ATTN = 2 * SHM_V + 2 * SHM_K + NW * 64 * 4;
#define KSWZ(row, colB) ((row) * 256 + ((colB) ^ (((row) & 7) << 4)))
#define SBAR() __builtin_amdgcn_sched_barrier(0)
__device__ __forceinline__ int crow(int r, int hi) { return (r & 3) + 8 * (r >> 2) + 4 * hi; }
__device__ __forceinline__ unsigned cvtpk(float lo, float hi) { unsigned r; asm volatile("v_cvt_pk_bf16_f32 %0, %1, %2" : "=v"(r) : "v"(lo), "v"(hi)); return r; }
__device__ __forceinline__ void partialSM(f32x16& p0, f32x16& p1, float& m_reg, float& mn, float& alpha) {
  constexpr float C = SCALE * 1.4426950408889634f;
  float pmax = p0[0]; for (int r = 1; r < 16; ++r) pmax = fmaxf(pmax, p0[r]); for (int r = 0; r < 16; ++r) pmax = fmaxf(pmax, p1[r]);
  { auto rr = __builtin_amdgcn_permlane32_swap(__float_as_uint(pmax), __float_as_uint(pmax), false, false);
    pmax = fmaxf(__uint_as_float(rr[0]), __uint_as_float(rr[1])); }
  if (__builtin_expect(__all(pmax - m_reg <= THR / SCALE), 1)) { mn = m_reg; alpha = 1.f; }
  else { mn = fmaxf(m_reg, pmax); alpha = __builtin_amdgcn_exp2f((m_reg - mn) * C); m_reg = mn; }
  float mnC = -mn * C;
  for (int r = 0; r < 16; ++r) p0[r] = fmaf(p0[r], C, mnC); for (int r = 0; r < 16; ++r) p1[r] = fmaf(p1[r], C, mnC);
  for (int r = 0; r < 16; ++r) p0[r] = __builtin_amdgcn_exp2f(p0[r]);
}
__device__ __forceinline__ void finishSM(f32x16& p0, f32x16& p1, float alpha, float& l_reg, bf16x8& pa0, bf16x8& pa1, bf16x8& pa2, bf16x8& pa3) {
  for (int r = 0; r < 16; ++r) p1[r] = __builtin_amdgcn_exp2f(p1[r]);
  float ps = 0; for (int r = 0; r < 16; ++r) ps += p0[r]; for (int r = 0; r < 16; ++r) ps += p1[r];
  { auto rr = __builtin_amdgcn_permlane32_swap(__float_as_uint(ps), __float_as_uint(ps), false, false);
    ps = __uint_as_float(rr[0]) + __uint_as_float(rr[1]); }
  l_reg = l_reg * alpha + ps;
#define PK4(P, BASE, OUT) do { unsigned a0 = cvtpk(P[BASE + 0], P[BASE + 1]), a1 = cvtpk(P[BASE + 2], P[BASE + 3]);   \
    unsigned b0 = cvtpk(P[BASE + 4], P[BASE + 5]), b1 = cvtpk(P[BASE + 6], P[BASE + 7]);                              \
    auto r0 = __builtin_amdgcn_permlane32_swap(a0, b0, false, false); auto r1 = __builtin_amdgcn_permlane32_swap(a1, b1, false, false); \
    u32x4 w = {r0[0], r1[0], r0[1], r1[1]}; OUT = *reinterpret_cast<bf16x8*>(&w); } while (0)
  PK4(p0, 0, pa0); PK4(p0, 8, pa1); PK4(p1, 0, pa2); PK4(p1, 8, pa3);
#undef PK4
}
__device__ __forceinline__ void qkt(f32x16& p0, f32x16& p1, const bf16_t* Ks, const bf16x8* qr, int r32, int hi) {
  p0 = f32x16{}; p1 = f32x16{};
  for (int d0 = 0; d0 < 8; ++d0) { int cb = (d0 * 16 + hi * 8) * 2;
    bf16x8 b0 = *reinterpret_cast<const bf16x8*>((const char*)Ks + KSWZ(r32, cb));
    bf16x8 b1 = *reinterpret_cast<const bf16x8*>((const char*)Ks + KSWZ(32 + r32, cb));
    p0 = __builtin_amdgcn_mfma_f32_32x32x16_bf16(b0, qr[d0], p0, 0, 0, 0);
    p1 = __builtin_amdgcn_mfma_f32_32x32x16_bf16(b1, qr[d0], p1, 0, 0, 0); }
}
__device__ __forceinline__ int v_st(int k, int c) { const int kk = (k & ~0xC) | ((k & 4) << 1) | ((k & 8) >> 1); return ((kk >> 3) * 4 + (c >> 5)) * 512 + ((kk & 7) * 32 + (c & 31)) * 2; }
__device__ __forceinline__ int v_rd_base(int lane) { return ((lane & 3) << 3) | (((lane >> 2) & 3) << 6) | (((lane >> 4) & 1) << 5) | (((lane >> 5) & 1) << 8); }
constexpr int v_rd_off(int d0, int ks, int half) { return d0 * 512 + ks * 4096 + half * 2048; }
template <int OFF> __device__ __forceinline__ s16x4 tr_read(int vb) {
  s16x4 r; asm volatile("ds_read_b64_tr_b16 %0, %1 offset:%2" : "=&v"(r) : "v"(vb), "i"(OFF) : "memory"); return r;
}
template <int D0> __device__ __forceinline__ void pv_one(f32x16& od, int vb, bf16x8 pa0, bf16x8 pa1, bf16x8 pa2, bf16x8 pa3) {
  const s16x4 l0 = tr_read<v_rd_off(D0, 0, 0)>(vb), h0 = tr_read<v_rd_off(D0, 0, 1)>(vb), l1 = tr_read<v_rd_off(D0, 1, 0)>(vb), h1 = tr_read<v_rd_off(D0, 1, 1)>(vb);
  const s16x4 l2 = tr_read<v_rd_off(D0, 2, 0)>(vb), h2 = tr_read<v_rd_off(D0, 2, 1)>(vb), l3 = tr_read<v_rd_off(D0, 3, 0)>(vb), h3 = tr_read<v_rd_off(D0, 3, 1)>(vb);
  asm volatile("s_waitcnt lgkmcnt(0)" ::: "memory"); SBAR();
#define PK(L, H) (bf16x8){L[0], L[1], L[2], L[3], H[0], H[1], H[2], H[3]}
  od = __builtin_amdgcn_mfma_f32_32x32x16_bf16(pa0, PK(l0, h0), od, 0, 0, 0);
  od = __builtin_amdgcn_mfma_f32_32x32x16_bf16(pa1, PK(l1, h1), od, 0, 0, 0);
  od = __builtin_amdgcn_mfma_f32_32x32x16_bf16(pa2, PK(l2, h2), od, 0, 0, 0);
  od = __builtin_amdgcn_mfma_f32_32x32x16_bf16(pa3, PK(l3, h3), od, 0, 0, 0);
#undef PK
}
__device__ __forceinline__ void pv_d0(f32x16* o, int vb, bf16x8 pa0, bf16x8 pa1, bf16x8 pa2, bf16x8 pa3) {
  pv_one<0>(o[0], vb, pa0, pa1, pa2, pa3); pv_one<1>(o[1], vb, pa0, pa1, pa2, pa3); pv_one<2>(o[2], vb, pa0, pa1, pa2, pa3); pv_one<3>(o[3], vb, pa0, pa1, pa2, pa3);
}
template <int LDQ, int LDK, int LDO>
__device__ __forceinline__ void attn_dense_body(const int tid, const bf16_t* __restrict__ Qb, const bf16_t* __restrict__ Kh, const bf16_t* __restrict__ Vh, bf16_t* __restrict__ Ob, int seq, char* lds) {
  constexpr int SDEPTH = 2;
  const int wid = tid >> 6, lane = tid & 63, r32 = lane & 31, hi = lane >> 5;
  bf16_t* V_lds = (bf16_t*)lds; bf16_t* K_lds = (bf16_t*)(lds + 2 * SHM_V);
  float* ws = (float*)(lds + 2 * SHM_V + 2 * SHM_K) + wid * 64; float* li_l = ws; float* al_l = ws + 32;
  float m_reg = -1e30f, l_reg = 0; f32x16 o[4] = {}; bf16x8 qr[8];
  const bf16_t* Qw = Qb + (long)(wid * QBLK + r32) * LDQ + hi * 8;
#pragma unroll
  for (int d0 = 0; d0 < 8; ++d0) qr[d0] = *reinterpret_cast<const bf16x8*>(Qw + d0 * 16);
  const int sr = tid >> 4, sc = (tid & 15) * 8, vst0 = v_st(sr, sc), vst1 = v_st(32 + sr, sc);
  const int vb0 = (int)(uintptr_t)V_lds + v_rd_base(lane);
  struct { bf16x8 vs0, vs1, ks0, ks1; } sr_[SDEPTH];
#define LD8(p) (*reinterpret_cast<const bf16x8*>(p))
#define SLOAD(i, k0) do { sr_[i].vs0 = LD8(&Vh[(long)((k0) + sr) * LDK + sc]); sr_[i].vs1 = LD8(&Vh[(long)((k0) + 32 + sr) * LDK + sc]); \
    sr_[i].ks0 = LD8(&Kh[(long)((k0) + sr) * LDK + sc]); sr_[i].ks1 = LD8(&Kh[(long)((k0) + 32 + sr) * LDK + sc]); } while (0)
#define SWRITE(b, i) do { *(bf16x8*)((char*)V_lds + (b) * SHM_V + vst0) = sr_[i].vs0;          \
    *(bf16x8*)((char*)V_lds + (b) * SHM_V + vst1) = sr_[i].vs1; int kc = sc * 2;               \
    *(bf16x8*)((char*)K_lds + (b) * SHM_K + KSWZ(sr, kc)) = sr_[i].ks0;                       \
    *(bf16x8*)((char*)K_lds + (b) * SHM_K + KSWZ(32 + sr, kc)) = sr_[i].ks1; } while (0)
#define SWAIT() do { asm volatile("s_waitcnt vmcnt(4)" ::: "memory"); } while (0)
#define RESC(a) do { if (__any((a) < 1.f)) { if (hi == 0) al_l[r32] = (a); asm volatile("s_waitcnt lgkmcnt(0)" ::: "memory"); \
    for (int d = 0; d < 4; ++d) for (int r = 0; r < 16; ++r) o[d][r] *= al_l[crow(r, hi)]; } } while (0)
  f32x16 pA0, pA1, pB0, pB1; float mnA, mnB, alA, alB; bf16x8 pa0, pa1, pa2, pa3; const int NT = seq / KVBLK;
  constexpr int SE = 0, SO = SDEPTH - 1;
  SLOAD(SE, 0); asm volatile("s_waitcnt vmcnt(0)" ::: "memory"); SWRITE(0, SE); __syncthreads();
  qkt(pA0, pA1, K_lds, qr, r32, hi); partialSM(pA0, pA1, m_reg, mnA, alA);
  SLOAD(SO, KVBLK); if (2 < NT) SLOAD(SE, 2 * KVBLK);
  SWAIT(); SWRITE(1, SO); __syncthreads();
  for (int j = 1; j + 1 < NT; j += 2) {
    SBAR(); qkt(pB0, pB1, (bf16_t*)((char*)K_lds + SHM_K), qr, r32, hi);
    finishSM(pA0, pA1, alA, l_reg, pa0, pa1, pa2, pa3); SBAR();
    SLOAD(SO, (j + SDEPTH) * KVBLK); SBAR();
    pv_d0(o, vb0, pa0, pa1, pa2, pa3); partialSM(pB0, pB1, m_reg, mnB, alB);
    __syncthreads(); SWAIT(); SWRITE(0, SE);
    RESC(alB); __syncthreads();
    SBAR(); qkt(pA0, pA1, K_lds, qr, r32, hi);
    finishSM(pB0, pB1, alB, l_reg, pa0, pa1, pa2, pa3); SBAR();
    if (j + 3 < NT) SLOAD(SE, (j + 1 + SDEPTH) * KVBLK); SBAR();
    pv_d0(o, vb0 + (int)SHM_V, pa0, pa1, pa2, pa3); partialSM(pA0, pA1, m_reg, mnA, alA);
    __syncthreads(); SWAIT(); SWRITE(1, SO);
    RESC(alA); __syncthreads();
  }
  SBAR(); qkt(pB0, pB1, (bf16_t*)((char*)K_lds + SHM_K), qr, r32, hi);
  finishSM(pA0, pA1, alA, l_reg, pa0, pa1, pa2, pa3); SBAR();
  pv_d0(o, vb0, pa0, pa1, pa2, pa3); partialSM(pB0, pB1, m_reg, mnB, alB);
  __syncthreads(); RESC(alB);
  finishSM(pB0, pB1, alB, l_reg, pa0, pa1, pa2, pa3); SBAR();
  pv_d0(o, vb0 + (int)SHM_V, pa0, pa1, pa2, pa3);
  if (hi == 0) li_l[r32] = l_reg; asm volatile("s_waitcnt lgkmcnt(0)" ::: "memory");
  float rli[16];
#pragma unroll
  for (int r = 0; r < 16; ++r) rli[r] = __builtin_amdgcn_rcpf(li_l[crow(r, hi)]);
  bf16_t* Ow = Ob + (long)(wid * QBLK) * LDO;
#pragma unroll
  for (int r = 0; r < 16; ++r) { int orow = crow(r, hi);
    for (int d0 = 0; d0 < 4; ++d0) Ow[(long)orow * LDO + d0 * 32 + r32] = (bf16_t)f2bf(o[d0][r] * rli[r]); }
#undef LD8
#undef SLOAD
#undef SWRITE
#undef SWAIT
#undef RESC
}
}

#define XB_TMO      128
#define XB_XCNT(j)  (256  + 64 * (j))
#define XB_XSUB(j)  (1280 + 64 * (j))
#define XB_XGEN(j)  (2304 + 64 * (j))
#define XB_TOP      3328
#define XB_TOPGEN   3392
#define XCD_BAR_WORDS 3456
#define XB_SPIN_CAP (1u << 18)
__device__ __forceinline__ unsigned xb_ld(unsigned* p)              { return __hip_atomic_load(p, __ATOMIC_RELAXED, __HIP_MEMORY_SCOPE_AGENT); }
__device__ __forceinline__ unsigned xb_add(unsigned* p, unsigned v) { return __hip_atomic_fetch_add(p, v, __ATOMIC_RELAXED, __HIP_MEMORY_SCOPE_AGENT); }
__device__ __forceinline__ unsigned xb_xcc_id() { return (unsigned)__builtin_amdgcn_s_getreg((3 << 11) | 20) & 0xFu; }
#define XB_SPIN(cond, bar) do { unsigned _sp = 0; while (cond) { __builtin_amdgcn_s_sleep(1); \
    if ((++_sp & 255u) == 0u) { if (xb_ld(&(bar)[XB_TMO])) break; if (_sp > XB_SPIN_CAP) { atomicAdd(&(bar)[XB_TMO], 1u); break; } } } } while (0)
struct XcdBarrier { unsigned* bar; unsigned x; volatile LAS unsigned* st; };
__device__ __forceinline__ XcdBarrier xcd_barrier_post(unsigned* bar, volatile LAS unsigned* st) {
    XcdBarrier b; b.bar = bar; b.x = xb_xcc_id(); b.st = st;
    if (threadIdx.x == 0) (void)xb_add(&bar[XB_XCNT(b.x)], 1u);
    return b;
}
__device__ __forceinline__ void xcd_barrier_complete(unsigned* bar, unsigned x, unsigned& nloc, unsigned& nx) {
    const unsigned G = gridDim.x * gridDim.y * gridDim.z;
    unsigned sum, cnt, mine, sp = 0u;
    for (;;) {
        sum = 0u; cnt = 0u; mine = 0u;
#pragma unroll
        for (unsigned j = 0; j < 16; ++j) { const unsigned c = xb_ld(&bar[XB_XCNT(j)]); sum += c; cnt += (c > 0u) ? 1u : 0u; mine = (j == x) ? c : mine; }
        if (sum == G) break;
        __builtin_amdgcn_s_sleep(1);
        if ((++sp & 255u) == 0u) { if (xb_ld(&bar[XB_TMO])) break; if (sp > XB_SPIN_CAP) { atomicAdd(&bar[XB_TMO], 1u); break; } }
    }
    nloc = mine > 0u ? mine : 1u; nx = cnt > 0u ? cnt : 1u;
}
__device__ __forceinline__ void xcd_barrier(const XcdBarrier& b) {
    asm volatile("s_waitcnt vmcnt(0)" ::: "memory");
    __syncthreads();
    if (threadIdx.x == 0) {
        unsigned* bar = b.bar;
        __builtin_amdgcn_s_waitcnt(0);
        unsigned nloc = b.st[0], nx = b.st[1];
        if (nloc == 0u) { xcd_barrier_complete(bar, b.x, nloc, nx); b.st[0] = nloc; b.st[1] = nx; }
        const unsigned old = xb_add(&bar[XB_XSUB(b.x)], 1u);
        const unsigned gen = old / nloc;
        if (old + 1u == (gen + 1u) * nloc) {
            __builtin_amdgcn_fence(__ATOMIC_RELEASE, "agent");
            asm volatile("s_waitcnt vmcnt(0)" ::: "memory");
            const unsigned og = xb_add(&bar[XB_TOP], 1u);
            const unsigned tg = og / nx;
            if (og + 1u == (tg + 1u) * nx) xb_add(&bar[XB_TOPGEN], 1u);
            else XB_SPIN(xb_ld(&bar[XB_TOPGEN]) == tg, bar);
            __builtin_amdgcn_fence(__ATOMIC_ACQUIRE, "agent");
            xb_add(&bar[XB_XGEN(b.x)], 1u);
            asm volatile("s_waitcnt vmcnt(0)" ::: "memory");
        } else {
            XB_SPIN(xb_ld(&bar[XB_XGEN(b.x)]) == gen, bar);
            __builtin_amdgcn_fence(__ATOMIC_ACQUIRE, "agent");
            asm volatile("s_waitcnt vmcnt(0)" ::: "memory");
        }
    }
    __syncthreads();
}

__device__ __forceinline__ void transpose_item(const float* W, int K, int N, bf16_t* WT, int mode, const float* gk, LAS float* scr, int item, int lane) {
    const int nblk = N / 32, kb = item / nblk, nb = item % nblk, k0 = 64 * kb, n0 = 32 * nb;
    const int r0 = mode == 0 ? n0 : ((n0 >> 7) * 256 + (n0 & 127) + (mode == 2 ? 128 : 0));
#pragma unroll 8
    for (int i = 0; i < 32; ++i) { const int kk = 2 * i + (lane >> 5); const float gv = gk ? gk[k0 + kk] : 1.0f; scr[kk * 33 + (lane & 31)] = W[(size_t)(k0 + kk) * N + n0 + (lane & 31)] * gv; }
    LDS_WAIT(); asm volatile("" ::: "memory");
    const int c = lane & 7;
#pragma unroll
    for (int j = 0; j < 4; ++j) { const int n = (lane >> 3) + 8 * j; const LAS float* s = scr + (8 * c) * 33 + n;
        u32x4 o; o.x = cvt_pk_bf16(s[0 * 33], s[1 * 33]); o.y = cvt_pk_bf16(s[2 * 33], s[3 * 33]); o.z = cvt_pk_bf16(s[4 * 33], s[5 * 33]); o.w = cvt_pk_bf16(s[6 * 33], s[7 * 33]);
        *(GAS u32x4*)(WT + (size_t)(r0 + n) * K + k0 + 8 * c) = o; }
    LDS_WAIT(); asm volatile("" ::: "memory");
}
__device__ __forceinline__ void transpose_matrix(const float* W, int K, int N, bf16_t* WT, int mode, const float* gk, LAS float* scr, int gw, int NGW, int lane, int& base) {
    const int n = (K / 64) * (N / 32);
    int first = (gw - base % NGW + NGW) % NGW;
    for (int it = first; it < n; it += NGW) transpose_item(W, K, N, WT, mode, gk, scr, it, lane);
    base += n;
}
__device__ __forceinline__ void convert_ffn_weights(const float* Wg, const float* Wu, const float* Wd, const float* gk, bf16_t* W1, bf16_t* WD, LAS float* scr, int gw, int NGW, int lane) {
    int base = 0;
    transpose_matrix(Wg, D, DFF, W1, 1, gk, scr, gw, NGW, lane, base);
    transpose_matrix(Wu, D, DFF, W1, 2, gk, scr, gw, NGW, lane, base);
    transpose_matrix(Wd, DFF, D, WD, 0, nullptr, scr, gw, NGW, lane, base);
}

template <bool FIRST, bool LAST>
__device__ __forceinline__ void rowpass(const float* xp, const float* xs, bf16_t* xb, float* xout, const bf16_t* f, float* rstd, const float* gpost, float scale, int gw, int NGW, int lane) {
    f32x4 gp[4][2];
#pragma unroll
    for (int j = 0; j < 4; ++j) { gp[j][0] = FIRST ? (f32x4){0.f, 0.f, 0.f, 0.f} : *(const f32x4*)(gpost + 512 * j + 8 * lane); gp[j][1] = FIRST ? (f32x4){0.f, 0.f, 0.f, 0.f} : *(const f32x4*)(gpost + 512 * j + 8 * lane + 4); }
    for (int row = gw; row < NTOK; row += NGW) {
        f32x4 x[4][2];
        if (FIRST) { const float* xrow = row < NPROMPT ? xp + (size_t)row * D : xs + (size_t)(row - NPROMPT) * D;
#pragma unroll
            for (int j = 0; j < 4; ++j) { x[j][0] = *(const GAS f32x4*)(xrow + 512 * j + 8 * lane); x[j][1] = *(const GAS f32x4*)(xrow + 512 * j + 8 * lane + 4); }
        } else {
            u32x4 xv[4], fv[4];
#pragma unroll
            for (int j = 0; j < 4; ++j) { xv[j] = *(const GAS u32x4*)(xb + (size_t)row * D + 512 * j + 8 * lane); fv[j] = *(const GAS u32x4*)(f + (size_t)row * D + 512 * j + 8 * lane); }
            float ss = 0.f; f32x4 ff[4][2];
#pragma unroll
            for (int j = 0; j < 4; ++j) { ff[j][0] = (f32x4){bf_lo(fv[j].x), bf_hi(fv[j].x), bf_lo(fv[j].y), bf_hi(fv[j].y)}; ff[j][1] = (f32x4){bf_lo(fv[j].z), bf_hi(fv[j].z), bf_lo(fv[j].w), bf_hi(fv[j].w)};
                x[j][0] = (f32x4){bf_lo(xv[j].x), bf_hi(xv[j].x), bf_lo(xv[j].y), bf_hi(xv[j].y)}; x[j][1] = (f32x4){bf_lo(xv[j].z), bf_hi(xv[j].z), bf_lo(xv[j].w), bf_hi(xv[j].w)};
#pragma unroll
                for (int h = 0; h < 2; ++h) ss += (ff[j][h].x * ff[j][h].x + ff[j][h].y * ff[j][h].y) + (ff[j][h].z * ff[j][h].z + ff[j][h].w * ff[j][h].w); }
            const float r = rsqrtf(wave_sum(ss, lane) * (1.0f / D) + 1e-6f) * scale;
#pragma unroll
            for (int j = 0; j < 4; ++j) { x[j][0] = x[j][0] + ff[j][0] * r * gp[j][0]; x[j][1] = x[j][1] + ff[j][1] * r * gp[j][1]; }
        }
        if (LAST) {
#pragma unroll
            for (int j = 0; j < 4; ++j) { *(GAS f32x4*)(xout + (size_t)row * D + 512 * j + 8 * lane) = x[j][0]; *(GAS f32x4*)(xout + (size_t)row * D + 512 * j + 8 * lane + 4) = x[j][1]; }
        } else {
            float s2 = 0.f;
#pragma unroll
            for (int j = 0; j < 4; ++j) { u32x4 w; w.x = cvt_pk_bf16(x[j][0].x, x[j][0].y); w.y = cvt_pk_bf16(x[j][0].z, x[j][0].w); w.z = cvt_pk_bf16(x[j][1].x, x[j][1].y); w.w = cvt_pk_bf16(x[j][1].z, x[j][1].w);
                *(GAS u32x4*)(xb + (size_t)row * D + 512 * j + 8 * lane) = w;
#pragma unroll
                for (int h = 0; h < 2; ++h) s2 += (x[j][h].x * x[j][h].x + x[j][h].y * x[j][h].y) + (x[j][h].z * x[j][h].z + x[j][h].w * x[j][h].w); }
            const float r2 = rsqrtf(wave_sum(s2, lane) * (1.0f / D) + 1e-6f);
            if (lane == 0) rstd[row] = r2;
        }
    }
}

__device__ __forceinline__ void sincos_d(double x, double& s, double& c) {
    const double n = rint(x * 0.63661977236758134308);
    double r = x - n * 1.57079632679489655800e+00; r = r - n * 6.12323399573676603587e-17;
    const long long q = (long long)n;
    const double r2 = r * r;
    double sp = -7.6471637318198164759e-13;
    sp = sp * r2 + 1.6059043836821614599e-10; sp = sp * r2 - 2.5052108385441718775e-08; sp = sp * r2 + 2.7557319223985890653e-06; sp = sp * r2 - 1.9841269841269841270e-04;
    sp = sp * r2 + 8.3333333333333333333e-03; sp = sp * r2 - 1.6666666666666666667e-01; const double sr = r + r * r2 * sp;
    double cp = 4.7794773323873852974e-14;
    cp = cp * r2 - 1.1470745597729724714e-11; cp = cp * r2 + 2.0876756987868098979e-09; cp = cp * r2 - 2.7557319223985890653e-07; cp = cp * r2 + 2.4801587301587301587e-05;
    cp = cp * r2 - 1.3888888888888888889e-03; cp = cp * r2 + 4.1666666666666666667e-02; cp = cp * r2 - 0.5; const double cr = 1.0 + r2 * cp;
    const int qq = (int)(q & 3);
    s = (qq == 0) ? sr : (qq == 1) ? cr : (qq == 2) ? -sr : -cr;
    c = (qq == 0) ? cr : (qq == 1) ? -sr : (qq == 2) ? -cr : sr;
}

struct Args { const float* in[27]; float* out; unsigned char* ws; int ph_lo, ph_hi; };
static_assert(sizeof(Args) == 29 * 8 + 8, "Args has no padding");

__host__ __device__ constexpr int mixer_phases(int kind) { return kind == 1 ? 4 : (kind == 0 ? 3 : 2); }
__host__ __device__ constexpr int total_phases() {
    int n = 2;
    for (int l = 0; l < NLAYER; ++l) n += 3 + mixer_phases(l % 3) + 2 + 4 + 3;
    return n;
}

typedef const __attribute__((address_space(4))) Args* KArgsP;
__global__ void __launch_bounds__(NTHREADS, 2) trunk_fwd(Args args) {
    extern __shared__ __attribute__((aligned(16))) unsigned char lds_raw[];
    LAS unsigned char* const lds = (LAS unsigned char*)lds_raw;
    volatile LAS unsigned* const MISC = (volatile LAS unsigned*)(lds + MISC_OFF);
    const int G = gridDim.x, bx = blockIdx.x;
    const int vcu = (G % 8 == 0) ? (bx % 8) * (G / 8) + bx / 8 : bx;
    const int NGW = G * NWAVES;
    const int wave_s = __builtin_amdgcn_readfirstlane((int)threadIdx.x >> 6);
    for (int u = threadIdx.x; u < (LDS_BYTES - RING_BYTES) / 4; u += NTHREADS) ((LAS unsigned*)(lds + RING_BYTES))[u] = 0u;
    __syncthreads();
    const int lo = args.ph_lo, hi = args.ph_hi;
    if (hi - lo > 1) (void)xcd_barrier_post((unsigned*)(args.ws + WS_CTL) + CW_BAR, MISC + 8);

    int ph = 0;
#define PH_BEGIN if (ph >= lo && ph < hi) { \
        KArgsP ap = (KArgsP)__builtin_amdgcn_kernarg_segment_ptr(); asm volatile("" : "+s"(ap)); \
        const int wave = wave_s; const int tid = wave_s * 64 + lane_id_asm(); \
        const int lane = tid & 63; const int gw = vcu * NWAVES + wave; \
        unsigned char* const ws = ap->ws; (void)lane; (void)gw; (void)ws;
#define PH_END } if (ph >= lo && ph + 1 < hi) { KArgsP ap2 = (KArgsP)__builtin_amdgcn_kernarg_segment_ptr(); asm volatile("" : "+s"(ap2)); \
        XcdBarrier b_; b_.bar = (unsigned*)(ap2->ws + WS_CTL) + CW_BAR; b_.x = xb_xcc_id(); b_.st = MISC + 8; xcd_barrier(b_); } ++ph;
#define WSP(T, OFF) ((T*)(ws + (OFF)))

    PH_BEGIN
        LAS float* scr = (LAS float*)(lds + wave * 16384);
        const float* a_w_in = ap->in[10]; const float* a_w_out = ap->in[15]; const float* ln_pre = ap->in[4];
        int base = 0;
        for (int s = 0; s < 2; ++s) transpose_matrix(a_w_in + (size_t)s * D * 4096, D, 4096, WSP(bf16_t, WS_AWIN) + (size_t)s * 4096 * D, 0, ln_pre + (size_t)(3 * s * 4 + 1) * D, scr, gw, NGW, lane, base);
        for (int s = 0; s < 2; ++s) transpose_matrix(a_w_out + (size_t)s * D * D, D, D, WSP(bf16_t, WS_AWOUT) + (size_t)s * D * D, 0, nullptr, scr, gw, NGW, lane, base);
        transpose_matrix(ap->in[16], D, 6144, WSP(bf16_t, WS_BWQKV), 0, ln_pre + (size_t)(1 * 4 + 1) * D, scr, gw, NGW, lane, base);
        transpose_matrix(ap->in[22], D, D, WSP(bf16_t, WS_BWOUT), 0, nullptr, scr, gw, NGW, lane, base);
        transpose_matrix(ap->in[23], D, D, WSP(bf16_t, WS_CWOUT), 0, nullptr, scr, gw, NGW, lane, base);
        for (int l = 0; l < NLAYER; ++l) {
            transpose_matrix(ap->in[24] + (size_t)l * D * 512, D, 512, WSP(bf16_t, WS_XWQ) + (size_t)l * 512 * D, 0, ln_pre + (size_t)(l * 4 + 2) * D, scr, gw, NGW, lane, base);
            transpose_matrix(ap->in[25] + (size_t)l * D * 1024, D, 1024, WSP(bf16_t, WS_XWKV) + (size_t)l * 1024 * D, 0, nullptr, scr, gw, NGW, lane, base);
            transpose_matrix(ap->in[26] + (size_t)l * 512 * D, 512, D, WSP(bf16_t, WS_XWOUT) + (size_t)l * D * 512, 0, nullptr, scr, gw, NGW, lane, base);
        }
        convert_ffn_weights(ap->in[7], ap->in[8], ap->in[9], ln_pre, WSP(bf16_t, WS_W1), WSP(bf16_t, WS_WD), scr, gw, NGW, lane);
        rowpass<true, false>(ap->in[0], ap->in[1], WSP(bf16_t, WS_H), nullptr, nullptr, WSP(float, WS_RSTD), nullptr, 1.f, gw, NGW, lane);
        { const float* mem_prompt = ap->in[2]; const float* mem_sample = ap->in[3]; const float* ln_mem = ap->in[6]; bf16_t* MEMN = WSP(bf16_t, WS_MEMN);
        for (int idx = gw; idx < NLAYER * NMEMTOK; idx += NGW) { const int l = idx / NMEMTOK, r = idx % NMEMTOK;
            const float* src = r < 256 ? mem_prompt + (size_t)r * D : mem_sample + (size_t)(r - 256) * D;
            const GAS f32x4* xr = (const GAS f32x4*)src + lane; f32x4 x[8]; float s2 = 0.f;
#pragma unroll
            for (int j = 0; j < 8; ++j) { x[j] = xr[64 * j]; s2 += (x[j].x * x[j].x + x[j].y * x[j].y) + (x[j].z * x[j].z + x[j].w * x[j].w); }
            const float r2 = rsqrtf(wave_sum(s2, lane) * (1.0f / D) + 1e-6f);
            GAS u32x2* ho = (GAS u32x2*)(MEMN + ((size_t)l * NMEMTOK + r) * D) + lane;
#pragma unroll
            for (int j = 0; j < 8; ++j) { const f32x4 g = *(const f32x4*)(ln_mem + l * D + 256 * j + 4 * lane); const f32x4 v = x[j] * r2 * g; u32x2 w; w.x = cvt_pk_bf16(v.x, v.y); w.y = cvt_pk_bf16(v.z, v.w); ho[64 * j] = w; } } }
        { float* ropeC = WSP(float, WS_ROPE_COS); float* ropeS = WSP(float, WS_ROPE_SIN); bf16_t* csT = WSP(bf16_t, WS_CS); bf16_t* wspT = WSP(bf16_t, WS_WSP); const float* a_w_s = ap->in[13];
        const float* gF = ln_pre + (size_t)(2 * 4 + 1) * D;
        const int gt = vcu * NTHREADS + tid, NGT = G * NTHREADS;
        for (int idx = gt; idx < 8192 * 16; idx += NGT) { const int pos = idx >> 4, j = idx & 15;
            const float invf = (float)exp(-13.122363377404328 * (double)j * 0.0625);
            const float ang = (float)pos * invf; double s, c; sincos_d((double)ang, s, c); ropeC[idx] = (float)c; ropeS[idx] = (float)s; }
        for (int idx = gt; idx < 8 * 512 * 256; idx += NGT) { const int g = idx >> 17, lp = (idx >> 8) & 511, cch = idx & 255, l = lp & 255; const float fr = (float)((l * cch) & 255) * (1.0f / 256.0f);
            csT[idx] = (bf16_t)f2bf((lp < 256 ? __builtin_amdgcn_cosf(fr) : __builtin_amdgcn_sinf(fr)) * gF[g * 256 + cch]); }
        for (int idx = gt; idx < 2 * 8 * 128 * 128; idx += NGT) wspT[idx] = (bf16_t)f2bf(a_w_s[idx]); }
    PH_END

    PH_BEGIN
        pg8::BatchOrder S; S.nM = 9; S.nN = 4; S.nZ = NLAYER; S.G = G; S.c = bx; S.ldc = 1024;
        S.sAm = (size_t)256 * D; S.sAz = (size_t)NMEMTOK * D; S.sBn = (size_t)256 * D; S.sBz = (size_t)1024 * D; S.sCm = (size_t)256 * 1024; S.sCn = 256; S.sCz = (size_t)NMEMTOK * 1024;
        pg8::EpiBf16<0, 0> E{WSP(bf16_t, WS_KV), 1.f, nullptr};
        pg8::gemm_phase(tid, lds, WSP(bf16_t, WS_MEMN), WSP(bf16_t, WS_XWKV), D, D, D / 64, S, E);
    PH_END

    for (int hl = 0; hl < 2 * NLAYER; ++hl) {
        const int layer = hl >> 1, which = hl & 1;
        PH_BEGIN
            pg8::StdOrder S; S.init(NTOK, 2 * DFF, D, D, DFF, G, bx);
            pg8::EpiSwiGLU E{WSP(bf16_t, WS_A), WSP(float, WS_RSTD)};
            PREP(1) pg8::gemm_phase(tid, lds, WSP(bf16_t, WS_H), WSP(bf16_t, WS_W1), D, D, D / 64, S, E);
        PH_END
        PH_BEGIN
            pg8::StdOrder S; S.init(NTOK, D, DFF, DFF, D, G, bx);
            pg8::EpiBf16<0, 0> E{WSP(bf16_t, WS_B), 1.f, nullptr};
            PREP(2) pg8::gemm_phase(tid, lds, WSP(bf16_t, WS_A), WSP(bf16_t, WS_WD), DFF, DFF, DFF / 64, S, E);
        PH_END
        PH_BEGIN
            const float* ln_pre = ap->in[4]; const float* ln_post = ap->in[5];
            const float* gpost = ln_post + (size_t)(layer * 4 + (which ? 3 : 0)) * D;
            if (hl == 2 * NLAYER - 1) rowpass<false, true>(nullptr, nullptr, WSP(bf16_t, WS_H), ap->out, WSP(bf16_t, WS_B), nullptr, gpost, 0.5f, gw, NGW, lane);
            else {
                rowpass<false, false>(nullptr, nullptr, WSP(bf16_t, WS_H), nullptr, WSP(bf16_t, WS_B), WSP(float, WS_RSTD), gpost, 0.5f, gw, NGW, lane);
                const size_t wo = (size_t)(hl + 1) * D * DFF; const int l2 = (hl + 1) >> 1, w2 = (hl + 1) & 1;
                PREP(4) convert_ffn_weights(ap->in[7] + wo, ap->in[8] + wo, ap->in[9] + wo, ln_pre + (size_t)(l2 * 4 + (w2 ? 3 : 0)) * D, WSP(bf16_t, WS_W1), WSP(bf16_t, WS_WD), (LAS float*)(lds + wave * 16384), gw, NGW, lane); }
        PH_END
        if (which == 0) {
            const int kind = layer % 3, slot = layer / 3;
            if (kind == 0) {
                PH_BEGIN
                    pg8::StdOrder S; S.init(NTOK, 4096, D, D, 4096, G, bx);
                    pg8::EpiBf16<1, 1> E{WSP(bf16_t, WS_A), 1.f, WSP(float, WS_RSTD)};
                    PREP(9) pg8::gemm_phase(tid, lds, WSP(bf16_t, WS_H), WSP(bf16_t, WS_AWIN) + (size_t)slot * 4096 * D, D, D, D / 64, S, E);
                PH_END
                PH_BEGIN
                    const bf16_t* RA = WSP(bf16_t, WS_A); f32x2* vstats = WSP(f32x2, WS_STATS);
                    PREP(7) for (int row = gw; row < NTOK; row += NGW) {
                        const GAS u32x4* vr = (const GAS u32x4*)(RA + (size_t)row * 4096 + 2048) + lane; u32x4 v[4]; float s = 0.f;
#pragma unroll
                        for (int j = 0; j < 4; ++j) { v[j] = vr[64 * j]; s += (bf_lo(v[j].x) + bf_hi(v[j].x)) + (bf_lo(v[j].y) + bf_hi(v[j].y)) + (bf_lo(v[j].z) + bf_hi(v[j].z)) + (bf_lo(v[j].w) + bf_hi(v[j].w)); }
                        const float mean = wave_sum(s, lane) * (1.0f / 2048.0f); float q = 0.f;
#pragma unroll
                        for (int j = 0; j < 4; ++j) { const unsigned w4[4] = {v[j].x, v[j].y, v[j].z, v[j].w};
#pragma unroll
                            for (int k = 0; k < 4; ++k) { const float a = bf_lo(w4[k]) - mean, b = bf_hi(w4[k]) - mean; q += a * a + b * b; } }
                        const float rstd = rsqrtf(wave_sum(q, lane) * (1.0f / 2048.0f) + 1e-5f);
                        if (lane == 0) vstats[row] = (f32x2){mean, rstd};
                    }
                PH_END
                PH_BEGIN
                    using namespace att;
                    const bf16_t* RA = WSP(bf16_t, WS_A); bf16_t* MX = WSP(bf16_t, WS_B); const f32x2* vstats = WSP(f32x2, WS_STATS); const bf16_t* wspT = WSP(bf16_t, WS_WSP);
                    const float* a_b_s = ap->in[14];
                    const int r32 = lane & 31, hi2 = lane >> 5, pb = wave & 3, ch = wave >> 2;
                    const int sr = tid >> 4, sc = (tid & 15) * 8, vst0 = v_st(sr, sc), vst1 = v_st(32 + sr, sc);
                    const int vb0 = (int)(uintptr_t)(lds_raw) + v_rd_base(lane);
                    const float* lng = ap->in[11] + (size_t)slot * 2048; const float* lnb = ap->in[12] + (size_t)slot * 2048;
                    PREP(7) for (int un = vcu; un < 320 * 8; un += G) {
                        const int g = un & 7, ck = un >> 3; const int tok0 = ck * 128;
                        __syncthreads();
#pragma unroll
                        for (int hc = 0; hc < 2; ++hc) {
                            const int gc = g * 256 + hc * 128 + sc;
                            const f32x4 g0 = *(const f32x4*)(lng + gc), g1 = *(const f32x4*)(lng + gc + 4), b0 = *(const f32x4*)(lnb + gc), b1 = *(const f32x4*)(lnb + gc + 4);
#pragma unroll
                            for (int kt = 0; kt < 2; ++kt)
#pragma unroll
                                for (int rr = 0; rr < 2; ++rr) { const int q = kt * 64 + rr * 32 + sr; const int tok = tok0 + q;
                                    const u32x4 raw = *(const GAS u32x4*)(RA + (size_t)tok * 4096 + 2048 + gc); const f32x2 st = vstats[tok];
                                    f32x4 a = (f32x4){bf_lo(raw.x), bf_hi(raw.x), bf_lo(raw.y), bf_hi(raw.y)}, b = (f32x4){bf_lo(raw.z), bf_hi(raw.z), bf_lo(raw.w), bf_hi(raw.w)};
                                    a = (a - st.x) * st.y * g0 + b0; b = (b - st.x) * st.y * g1 + b1;
                                    u32x4 w; w.x = cvt_pk_bf16(a.x, a.y); w.y = cvt_pk_bf16(a.z, a.w); w.z = cvt_pk_bf16(b.x, b.y); w.w = cvt_pk_bf16(b.z, b.w);
                                    *(LAS u32x4*)(lds + (kt * 2 + hc) * 16384 + (rr ? vst1 : vst0)) = w; }
                        }
                        bf16x8 pa[2][4];
                        const bf16_t* wrow = wspT + ((size_t)(slot * 8 + g) * 128 + 32 * pb + r32) * 128 + 8 * hi2;
#pragma unroll
                        for (int kt = 0; kt < 2; ++kt)
#pragma unroll
                            for (int i = 0; i < 4; ++i) pa[kt][i] = *(const bf16x8*)(wrow + kt * 64 + 16 * i);
                        __syncthreads();
                        f32x16 o[4] = {};
                        pv_d0(o, vb0 + (0 * 2 + ch) * 16384, pa[0][0], pa[0][1], pa[0][2], pa[0][3]);
                        pv_d0(o, vb0 + (1 * 2 + ch) * 16384, pa[1][0], pa[1][1], pa[1][2], pa[1][3]);
#pragma unroll
                        for (int r = 0; r < 16; ++r) { const int p = 32 * pb + crow(r, hi2); const int tok = tok0 + p; const float bias = a_b_s[(size_t)(slot * 8 + g) * 128 + p];
#pragma unroll
                            for (int d0 = 0; d0 < 4; ++d0) { const int c = g * 256 + ch * 128 + d0 * 32 + r32;
                                const float uu = bf_lo((unsigned)RA[(size_t)tok * 4096 + c]);
                                MX[(size_t)tok * D + c] = (bf16_t)f2bf(uu * (o[d0][r] + bias)); } }
                    }
                    __syncthreads();
                PH_END
            } else if (kind == 1) {
                PH_BEGIN
                    pg8::StdOrder S; S.init(NTOK, 6144, D, D, 6144, G, bx);
                    pg8::EpiBf16<0, 1> E{WSP(bf16_t, WS_A), 1.f, WSP(float, WS_RSTD)};
                    PREP(9) pg8::gemm_phase(tid, lds, WSP(bf16_t, WS_H), WSP(bf16_t, WS_BWQKV), D, D, D / 64, S, E);
                PH_END
                PH_BEGIN
                    bf16_t* RA = WSP(bf16_t, WS_A); const float* ropeC = WSP(float, WS_ROPE_COS); const float* ropeS = WSP(float, WS_ROPE_SIN);
                    const int v = lane >> 1, half = lane & 1;
                    const int colbase = (v < 16 ? v * 128 : 2048 + (v - 16) * 128) + 8 * half;
                    for (int row = gw; row < NTOK; row += NGW) {
                        const int pos = row < NPROMPT ? row : (row & (SSAMP - 1));
                        GAS u32x4* p1 = (GAS u32x4*)(RA + (size_t)row * 6144 + colbase); GAS u32x4* p2 = (GAS u32x4*)(RA + (size_t)row * 6144 + colbase + 16);
                        const u32x4 a = *p1, b = *p2;
                        const f32x4 c0 = *(const f32x4*)(ropeC + pos * 16 + 8 * half), c1 = *(const f32x4*)(ropeC + pos * 16 + 8 * half + 4), s0 = *(const f32x4*)(ropeS + pos * 16 + 8 * half), s1 = *(const f32x4*)(ropeS + pos * 16 + 8 * half + 4);
                        const float x1[8] = {bf_lo(a.x), bf_hi(a.x), bf_lo(a.y), bf_hi(a.y), bf_lo(a.z), bf_hi(a.z), bf_lo(a.w), bf_hi(a.w)};
                        const float x2[8] = {bf_lo(b.x), bf_hi(b.x), bf_lo(b.y), bf_hi(b.y), bf_lo(b.z), bf_hi(b.z), bf_lo(b.w), bf_hi(b.w)};
                        const float cc[8] = {c0.x, c0.y, c0.z, c0.w, c1.x, c1.y, c1.z, c1.w}, sn[8] = {s0.x, s0.y, s0.z, s0.w, s1.x, s1.y, s1.z, s1.w};
                        float o1[8], o2[8];
#pragma unroll
                        for (int j = 0; j < 8; ++j) { o1[j] = x1[j] * cc[j] - x2[j] * sn[j]; o2[j] = x2[j] * cc[j] + x1[j] * sn[j]; }
                        *p1 = (u32x4){cvt_pk_bf16(o1[0], o1[1]), cvt_pk_bf16(o1[2], o1[3]), cvt_pk_bf16(o1[4], o1[5]), cvt_pk_bf16(o1[6], o1[7])};
                        *p2 = (u32x4){cvt_pk_bf16(o2[0], o2[1]), cvt_pk_bf16(o2[2], o2[3]), cvt_pk_bf16(o2[4], o2[5]), cvt_pk_bf16(o2[6], o2[7])};
                    }
                PH_END
                PH_BEGIN
                    const bf16_t* RA = WSP(bf16_t, WS_A); bf16_t* RB = WSP(bf16_t, WS_B);
                    PREP(5) for (int idx = vcu; idx < 5120; idx += G) {
                        int h16, vh, qb, seq; size_t t0;
                        if (idx < 1024) { const int i = idx >> 8, w = idx & 255; const int combo = (w >> 5) * 4 + i; qb = w & 31; h16 = combo >> 1; vh = combo & 1; t0 = 0; seq = NPROMPT; }
                        else { const int id2 = idx - 1024; h16 = id2 >> 8; const int w = id2 & 255; const int b = w >> 5, jj = w & 31; vh = jj >> 4; qb = jj & 15; t0 = (size_t)NPROMPT + (size_t)b * SSAMP; seq = SSAMP; }
                        const bf16_t* Q = RA + (t0 + qb * 256) * 6144 + h16 * 128; const bf16_t* K = RA + t0 * 6144 + 2048 + h16 * 128; const bf16_t* V = RA + t0 * 6144 + 4096 + (h16 >> 1) * 256 + vh * 128;
                        bf16_t* O = RB + (size_t)(h16 & 1) * NTOK * D + (t0 + qb * 256) * D + (h16 >> 1) * 256 + vh * 128;
                        const int tid2 = wave * 64 + lane_id_asm();
                        att::attn_dense_body<6144, 6144, 2048>(tid2, Q, K, V, O, seq, (char*)lds_raw); __syncthreads(); }
                PH_END
                PH_BEGIN
                    const float* b_lq1 = ap->in[17]; const float* b_lk1 = ap->in[18]; const float* b_lq2 = ap->in[19]; const float* b_lk2 = ap->in[20]; const float* b_subln = ap->in[21];
                    const float lam_init = 0.8f - 0.6f * expf(-0.3f * (float)layer);
                    float d1 = b_lq1[lane] * b_lk1[lane] + b_lq1[lane + 64] * b_lk1[lane + 64], d2 = b_lq2[lane] * b_lk2[lane] + b_lq2[lane + 64] * b_lk2[lane + 64];
                    const float lam = expf(wave_sum(d1, lane)) - expf(wave_sum(d2, lane)) + lam_init;
                    const f32x4 sg = *(const f32x4*)(b_subln + 4 * lane); const float osc = 1.0f - lam_init;
                    const bf16_t* O0 = WSP(bf16_t, WS_B); const bf16_t* O1 = O0 + (size_t)NTOK * D; bf16_t* CO = WSP(bf16_t, WS_A);
                    for (int row = gw; row < NTOK; row += NGW) {
                        const GAS u32x2* p0 = (const GAS u32x2*)(O0 + (size_t)row * D) + lane; const GAS u32x2* p1 = (const GAS u32x2*)(O1 + (size_t)row * D) + lane;
                        GAS u32x2* po = (GAS u32x2*)(CO + (size_t)row * D) + lane;
                        u32x2 a[8], b[8];
#pragma unroll
                        for (int j = 0; j < 8; ++j) { a[j] = p0[64 * j]; b[j] = p1[64 * j]; }
#pragma unroll
                        for (int j = 0; j < 8; ++j) { f32x4 dv = (f32x4){bf_lo(a[j].x) - lam * bf_lo(b[j].x), bf_hi(a[j].x) - lam * bf_hi(b[j].x), bf_lo(a[j].y) - lam * bf_lo(b[j].y), bf_hi(a[j].y) - lam * bf_hi(b[j].y)};
                            const float ss = wave_sum((dv.x * dv.x + dv.y * dv.y) + (dv.z * dv.z + dv.w * dv.w), lane); const float r = rsqrtf(ss * (1.0f / 256.0f) + 1e-5f) * osc;
                            dv = dv * r * sg; u32x2 w; w.x = cvt_pk_bf16(dv.x, dv.y); w.y = cvt_pk_bf16(dv.z, dv.w); po[64 * j] = w; }
                    }
                PH_END
            } else {
                PH_BEGIN
                    {
                        bf16_t* Tp = WSP(bf16_t, WS_B); bf16_t* Ts = Tp + (size_t)8192 * 16384;
                        const long gt = (long)vcu * NTHREADS + tid, NGT = (long)G * NTHREADS;
                        for (long it = gt; it < (long)8192 * 2048; it += NGT) { const int k = (int)(it >> 11), c8 = (int)(it & 2047), part = c8 >> 10, s0 = (c8 & 1023) * 8; unsigned w[4];
#pragma unroll
                            for (int e = 0; e < 4; ++e) { const float f0 = (float)((k * (s0 + 2 * e)) & 8191) * (1.0f / 8192.0f), f1 = (float)((k * (s0 + 2 * e + 1)) & 8191) * (1.0f / 8192.0f);
                                const float v0 = part ? -__builtin_amdgcn_sinf(f0) : __builtin_amdgcn_cosf(f0), v1 = part ? -__builtin_amdgcn_sinf(f1) : __builtin_amdgcn_cosf(f1); w[e] = cvt_pk_bf16(v0, v1); }
                            *(GAS u32x4*)(Tp + (size_t)k * 16384 + part * 8192 + s0) = (u32x4){w[0], w[1], w[2], w[3]}; }
                        for (long it = gt; it < (long)4096 * 1024; it += NGT) { const int k = (int)(it >> 10), c8 = (int)(it & 1023), part = c8 >> 9, s0 = (c8 & 511) * 8; unsigned w[4];
#pragma unroll
                            for (int e = 0; e < 4; ++e) { const float f0 = (float)((k * (s0 + 2 * e)) & 4095) * (1.0f / 4096.0f), f1 = (float)((k * (s0 + 2 * e + 1)) & 4095) * (1.0f / 4096.0f);
                                const float v0 = part ? -__builtin_amdgcn_sinf(f0) : __builtin_amdgcn_cosf(f0), v1 = part ? -__builtin_amdgcn_sinf(f1) : __builtin_amdgcn_cosf(f1); w[e] = cvt_pk_bf16(v0, v1); }
                            *(GAS u32x4*)(Ts + (size_t)k * 8192 + part * 4096 + s0) = (u32x4){w[0], w[1], w[2], w[3]}; }
                    }
                    pg8::F1Order S; S.G = G; S.c = bx;
                    pg8::EpiBf16<0, 2> E{WSP(bf16_t, WS_A), 1.f, WSP(float, WS_RSTD)};
                    int nt4 = 4; asm volatile("" : "+s"(nt4));
                    pg8::gemm_phase(tid, lds, WSP(bf16_t, WS_CS), WSP(bf16_t, WS_H), 256, D, nt4, S, E);
                PH_END
                PH_BEGIN
                    bf16_t* Y = WSP(bf16_t, WS_A + 320 * MiB);
                    {   pg8::StdOrder S; S.init(NPROMPT, D, 16384, 16384, D, G, bx);
                        pg8::EpiBf16<0, 0> E{Y, 6.9053396600248786e-04f, nullptr};
                        pg8::gemm_phase(tid, lds, WSP(bf16_t, WS_B), WSP(bf16_t, WS_A), 16384, 16384, 256, S, E); }
                    {   pg8::BatchOrder S; S.nM = 16; S.nN = 8; S.nZ = 8; S.G = G; S.c = bx; S.ldc = D;
                        S.sAm = (size_t)256 * 8192; S.sAz = 0; S.sBn = (size_t)256 * 8192; S.sBz = (size_t)2048 * 8192; S.sCm = (size_t)256 * D; S.sCn = 256; S.sCz = (size_t)SSAMP * D;
                        pg8::EpiBf16<0, 0> E{Y + (size_t)NPROMPT * D, 9.765625e-04f, nullptr};
                        pg8::gemm_phase(tid, lds, WSP(bf16_t, WS_B) + (size_t)8192 * 16384, WSP(bf16_t, WS_A) + (size_t)2048 * 16384, 8192, 8192, 128, S, E); }
                PH_END
            }
            PH_BEGIN
                const bf16_t* WOT = kind == 0 ? WSP(bf16_t, WS_AWOUT) + (size_t)slot * D * D : (kind == 1 ? WSP(bf16_t, WS_BWOUT) : WSP(bf16_t, WS_CWOUT));
                const bf16_t* MXI = kind == 0 ? WSP(bf16_t, WS_B) : (kind == 1 ? WSP(bf16_t, WS_A) : WSP(bf16_t, WS_A + 320 * MiB));
                pg8::StdOrder S; S.init(NTOK, D, D, D, D, G, bx);
                pg8::EpiBf16<0, 0> E{kind == 1 ? WSP(bf16_t, WS_B) : WSP(bf16_t, WS_A), 1.f, nullptr};
                PREP(9) pg8::gemm_phase(tid, lds, MXI, WOT, D, D, D / 64, S, E);
            PH_END
            PH_BEGIN
                rowpass<false, false>(nullptr, nullptr, WSP(bf16_t, WS_H), nullptr, kind == 1 ? WSP(bf16_t, WS_B) : WSP(bf16_t, WS_A), WSP(float, WS_RSTD), ap->in[5] + (size_t)(layer * 4 + 1) * D, 1.0f, gw, NGW, lane);
            PH_END
            PH_BEGIN
                pg8::StdOrder S; S.init(NTOK, 512, D, D, 512, G, bx);
                pg8::EpiBf16<0, 1> E{WSP(bf16_t, WS_A), 1.f, WSP(float, WS_RSTD)};
                PREP(9) pg8::gemm_phase(tid, lds, WSP(bf16_t, WS_H), WSP(bf16_t, WS_XWQ) + (size_t)layer * 512 * D, D, D, D / 64, S, E);
            PH_END
            PH_BEGIN
                const bf16_t* QX = WSP(bf16_t, WS_A); bf16_t* OX = WSP(bf16_t, WS_A) + (size_t)NTOK * 512;
                const bf16_t* KVl = WSP(bf16_t, WS_KV) + (size_t)layer * NMEMTOK * 1024;
                PREP(8) for (int idx = vcu; idx < 640; idx += G) { const int tb = idx >> 2, head = idx & 3; const int bm = tb < 32 ? 0 : 1 + ((tb - 32) >> 4);
                    const bf16_t* Q = QX + (size_t)tb * 256 * 512 + head * 128; const bf16_t* K = KVl + (size_t)bm * 256 * 1024 + head * 128; const bf16_t* V = K + 512;
                    bf16_t* O = OX + (size_t)tb * 256 * 512 + head * 128;
                    const int tid2 = wave * 64 + lane_id_asm();
                    att::attn_dense_body<512, 1024, 512>(tid2, Q, K, V, O, 256, (char*)lds_raw); __syncthreads(); }
            PH_END
            PH_BEGIN
                pg8::StdOrder S; S.init(NTOK, D, 512, 512, D, G, bx);
                pg8::EpiBf16<0, 0> E{WSP(bf16_t, WS_A) + (size_t)NTOK * 1024, 1.f, nullptr};
                PREP(9) pg8::gemm_phase(tid, lds, WSP(bf16_t, WS_A) + (size_t)NTOK * 512, WSP(bf16_t, WS_XWOUT) + (size_t)layer * D * 512, 512, 512, 8, S, E);
            PH_END
            PH_BEGIN
                rowpass<false, false>(nullptr, nullptr, WSP(bf16_t, WS_H), nullptr, WSP(bf16_t, WS_A) + (size_t)NTOK * 1024, WSP(float, WS_RSTD), ap->in[5] + (size_t)(layer * 4 + 2) * D, 1.0f, gw, NGW, lane);
            PH_END
        }
    }
#undef PH_BEGIN
#undef PH_END
#undef WSP
}

extern "C" void kernel_launch(void* const* d_in, const int* in_sizes, int n_in, void* d_out, int out_size, void* d_ws, size_t ws_size, hipStream_t stream) {
    static int grid = 0;
    if (grid == 0) {
        if (n_in != 27 || out_size != NTOK * D || ws_size < WS_END) { fprintf(stderr, "kernel_launch: unexpected shapes: n_in %d out %d ws %zu (need %zu)\n", n_in, out_size, ws_size, (size_t)WS_END); grid = -1; return; }
        int dev = 0, cus = 0, per_cu = 0;
        if (hipGetDevice(&dev) != hipSuccess || hipDeviceGetAttribute(&cus, hipDeviceAttributeMultiprocessorCount, dev) != hipSuccess) { grid = -1; return; }
        if (hipFuncSetAttribute((const void*)trunk_fwd, hipFuncAttributeMaxDynamicSharedMemorySize, LDS_BYTES) != hipSuccess) { fprintf(stderr, "kernel_launch: hipFuncSetAttribute failed\n"); grid = -1; return; }
        if (hipOccupancyMaxActiveBlocksPerMultiprocessor(&per_cu, (const void*)trunk_fwd, NTHREADS, LDS_BYTES) != hipSuccess || per_cu < 1) fprintf(stderr, "kernel_launch: occupancy query reports %d\n", per_cu);
        (void)hipGetLastError();
        grid = cus;
    }
    if (grid < 0) return;
    (void)hipMemsetAsync((char*)d_ws + WS_CTL, 0, CTL_ZERO_BYTES, stream);
    Args a{};
    for (int i = 0; i < 27; ++i) a.in[i] = (const float*)d_in[i];
    a.out = (float*)d_out; a.ws = (unsigned char*)d_ws;
    constexpr int NPH = total_phases();
#if MK_PER_PHASE
    for (int p = 0; p < NPH; ++p) { a.ph_lo = p; a.ph_hi = p + 1; hipLaunchKernelGGL(trunk_fwd, dim3(grid), dim3(NTHREADS), LDS_BYTES, stream, a); }
#else
    a.ph_lo = 0; a.ph_hi = NPH; hipLaunchKernelGGL(trunk_fwd, dim3(grid), dim3(NTHREADS), LDS_BYTES, stream, a);
#endif
    const hipError_t le = hipPeekAtLastError();
    if (le != hipSuccess) fprintf(stderr, "kernel_launch: launch failed: %s\n", hipGetErrorName(le));
}
```

```cpp
#include <hip/hip_runtime.h>
#include <cstdio>
#include <cstdint>

#ifndef PROBE_ID
#define PROBE_ID 0
#endif
#ifndef PROBE_T
#define PROBE_T 0
#endif
#define PROBE_AMP 4
#define PREP(k) for (int rep_ = 0; rep_ < ((PROBE_ID == (k)) ? 2 : 1); ++rep_)
#ifndef MK_PER_PHASE
#define MK_PER_PHASE 0
#endif

#define LAS __attribute__((address_space(3)))
#define GAS __attribute__((address_space(1)))
typedef unsigned short bf16_t;
typedef short bf16x8 __attribute__((ext_vector_type(8)));
typedef short s16x4 __attribute__((ext_vector_type(4)));
typedef float f32x2 __attribute__((ext_vector_type(2)));
typedef float f32x4 __attribute__((ext_vector_type(4)));
typedef float f32x16 __attribute__((ext_vector_type(16)));
typedef unsigned u32x2 __attribute__((ext_vector_type(2)));
typedef unsigned u32x4 __attribute__((ext_vector_type(4)));

constexpr int D = 2048, NTOK = 40960, NPROMPT = 8192, SSAMP = 4096, DFF = 5504, NMEMTOK = 2304, NLAYER = 4;
constexpr int NWAVES = 8, NTHREADS = 512;

constexpr size_t MiB = 1u << 20;
constexpr size_t WS_CTL = 0, CTL_ZERO_BYTES = 1 * MiB;
constexpr size_t WS_ROPE_COS = 1 * MiB, WS_ROPE_SIN = WS_ROPE_COS + 512 * 1024;
constexpr size_t WS_WSP = 2 * MiB;
constexpr size_t WS_STATS = 2 * MiB + 512 * 1024;
constexpr size_t WS_RSTD = 3 * MiB;
constexpr size_t WS_KV = 4 * MiB;
constexpr size_t WS_MEMN = 22 * MiB;
constexpr size_t WS_AWIN = 58 * MiB;
constexpr size_t WS_AWOUT = 90 * MiB;
constexpr size_t WS_BWQKV = 106 * MiB;
constexpr size_t WS_BWOUT = 130 * MiB;
constexpr size_t WS_CWOUT = 138 * MiB;
constexpr size_t WS_XWQ = 146 * MiB;
constexpr size_t WS_XWKV = 154 * MiB;
constexpr size_t WS_XWOUT = 170 * MiB;
constexpr size_t WS_W1 = 178 * MiB;
constexpr size_t WS_WD = 221 * MiB;
constexpr size_t WS_H = 244 * MiB;
constexpr size_t WS_A = 404 * MiB;
constexpr size_t WS_B = 884 * MiB;
constexpr size_t WS_CS = 1204 * MiB;
constexpr size_t WS_END = 1206 * MiB;
constexpr int CW_BAR = 4096;

constexpr int RING_BYTES = 131072;
constexpr int MISC_OFF = RING_BYTES + 320;
constexpr int LDS_BYTES = 147456;

__device__ __forceinline__ unsigned f2bf(float f) { unsigned u = __builtin_bit_cast(unsigned, f); return (u + 0x7fffu + ((u >> 16) & 1u)) >> 16; }
__device__ __forceinline__ unsigned cvt_pk_bf16(float lo, float hi) { unsigned r; asm volatile("v_cvt_pk_bf16_f32 %0, %1, %2" : "=v"(r) : "v"(lo), "v"(hi)); return r; }
__device__ __forceinline__ float bf_lo(unsigned w) { return __builtin_bit_cast(float, w << 16); }
__device__ __forceinline__ float bf_hi(unsigned w) { return __builtin_bit_cast(float, w & 0xffff0000u); }
__device__ __forceinline__ float wave_sum(float v, int lane) {
#pragma unroll
    for (int o = 1; o < 64; o <<= 1) v += __builtin_bit_cast(float, __builtin_amdgcn_ds_bpermute((lane ^ o) << 2, __builtin_bit_cast(int, v)));
    return v;
}
__device__ __forceinline__ int lane_id_asm() { int l; asm volatile("v_mbcnt_lo_u32_b32 %0, -1, 0\n\tv_mbcnt_hi_u32_b32 %0, -1, %0" : "=v"(l)); return l; }
#define LDS_WAIT() asm volatile("s_waitcnt lgkmcnt(0)" ::: "memory")
#define VM_WAIT() asm volatile("s_waitcnt vmcnt(0)" ::: "memory")

namespace pg8 {
constexpr int BM = 256, BK = 64, HALF = 128, HTB = HALF * BK * 2, STAGE_BYTES = 8 * HTB, NXCD = 8, WGM = 8;
__host__ __device__ __forceinline__ int lds_byte(int r, int c) { const int st = (r >> 4) * 2 + (c >> 5), rr = r & 15, cc = c & 31, ob = rr * 64 + cc * 2; return st * 1024 + (ob ^ (((ob >> 9) & 1) << 5)); }
__host__ __device__ __forceinline__ void stage_rc(int b, int& R, int& C) { const int st = b / 1024, sb = b % 1024, swz = sb ^ (((sb >> 9) & 1) << 5); R = (st >> 1) * 16 + swz / 64; C = (st & 1) * 32 + (swz % 64) / 2; }
__host__ __device__ __forceinline__ int perm32(int rho) { const int n = rho >> 4, i = rho & 15; return 8 * (i >> 2) + 4 * n + (i & 3); }

struct Unit { int pm, pn, z, ldc; size_t offA, offB, offC; };

struct StdOrder {
    int nM, nN, nwg, G, c, ldc; size_t sA, sB, sCm, sCn;
    __device__ void init(int M, int N, int lda, int ldb, int ldc_, int G_, int c_, int cn = 256) { nM = M / BM; nN = N / BM; nwg = nM * nN; G = G_; c = c_; ldc = ldc_; sA = (size_t)BM * lda; sB = (size_t)BM * ldb; sCm = (size_t)BM * ldc_; sCn = (size_t)cn; }
    __device__ __forceinline__ bool next(int i, Unit& u) const {
        const long L = (long)i * G + c; if (L >= nwg) return false;
        int wgid = (int)L; { const int q = nwg / NXCD, r = nwg % NXCD, xcd = wgid % NXCD, off = wgid / NXCD; wgid = (xcd < r ? xcd * (q + 1) : r * (q + 1) + (xcd - r) * q) + off; }
        const int nig = WGM * nN, gid = wgid / nig, fm = gid * WGM, gsz = (nM - fm) < WGM ? (nM - fm) : WGM;
        u.pm = fm + ((wgid % nig) % gsz); u.pn = (wgid % nig) / gsz; u.z = 0; u.ldc = ldc;
        u.offA = (size_t)u.pm * sA; u.offB = (size_t)u.pn * sB; u.offC = (size_t)u.pm * sCm + (size_t)u.pn * sCn; return true;
    }
};
struct BatchOrder {
    int nM, nN, nZ, G, c, ldc; size_t sAm, sAz, sBn, sBz, sCm, sCn, sCz;
    __device__ __forceinline__ bool next(int i, Unit& u) const {
        const long L = (long)i * G + c; const int per = nM * nN; if (L >= (long)per * nZ) return false;
        const int z = (int)(L / per), r = (int)(L % per); u.z = z; u.pm = r % nM; u.pn = r / nM; u.ldc = ldc;
        u.offA = (size_t)u.pm * sAm + (size_t)z * sAz; u.offB = (size_t)u.pn * sBn + (size_t)z * sBz; u.offC = (size_t)u.pm * sCm + (size_t)u.pn * sCn + (size_t)z * sCz; return true;
    }
};
struct F1Order {
    int G, c;
    __device__ __forceinline__ bool next(int i, Unit& u) const {
        const long L = (long)i * G + c; if (L >= 2560) return false;
        const int g = (int)(L / 320), r = (int)(L % 320); u.z = g; u.pm = r & 1; u.pn = r >> 1;
        u.offA = (size_t)g * 512 * 256 + (size_t)u.pm * 256 * 256; u.offB = (size_t)u.pn * 256 * 2048 + (size_t)g * 256;
        if (u.pn < 32) { u.ldc = 16384; u.offC = (size_t)(g * 256) * 16384 + (size_t)u.pm * 8192 + (size_t)u.pn * 256; }
        else { const int rr = u.pn - 32, bb = rr >> 4, s0 = (rr & 15) * 256; u.ldc = 8192; u.offC = (size_t)2048 * 16384 + (size_t)bb * 2048 * 8192 + (size_t)(g * 256) * 8192 + (size_t)u.pm * 4096 + s0; }
        return true;
    }
};

__device__ __forceinline__ f32x2 gelu_pk(f32x2 v) {
    const f32x2 av = __builtin_elementwise_abs(v), d = av * 0.2316418882f + 1.0f;
    f32x2 t; t.x = __builtin_amdgcn_rcpf(d.x); t.y = __builtin_amdgcn_rcpf(d.y);
    f32x2 q = t * 0.5307027145f + (-0.7265760135f); q = q * t + 0.7107068705f; q = q * t + (-0.142248368f); q = q * t + 0.127414796f; q = q * t;
    const f32x2 s = (v * v) * (-0.72134752044f);
    f32x2 e; e.x = __builtin_amdgcn_exp2f(s.x); e.y = __builtin_amdgcn_exp2f(s.y);
    const f32x2 m = v * (q * e), r = v - m;
    f32x2 o; o.x = v.x < 0.f ? m.x : r.x; o.y = v.y < 0.f ? m.y : r.y; return o;
}
template <int ACT  , int SM = 0> struct EpiBf16 {
    bf16_t* O; float scale; const float* rs;
    __device__ __forceinline__ void operator()(const f32x4 (&acc)[2][2][4][2], const Unit& u, int wr, int wc, int fr, int fq) const {
        bf16_t* base = O + u.offC + (size_t)(wr * 64 + fr) * u.ldc + wc * 32 + 8 * fq;
        f32x4 cs0[2], cs1[2];
        if (SM == 2) {
#pragma unroll
            for (int bj = 0; bj < 2; ++bj) { const float* p = rs + u.pn * BM + bj * HALF + wc * 32 + 8 * fq; cs0[bj] = *(const f32x4*)p; cs1[bj] = *(const f32x4*)(p + 4); } }
#pragma unroll
        for (int ai = 0; ai < 2; ++ai)
#pragma unroll
            for (int m = 0; m < 4; ++m) { bf16_t* rowp = base + (size_t)(ai * HALF + m * 16) * u.ldc;
                float rsc = scale; if (SM == 1) rsc = rs[u.pm * BM + ai * HALF + wr * 64 + m * 16 + fr] * scale;
#pragma unroll
                for (int bj = 0; bj < 2; ++bj) { f32x4 v0 = acc[ai][bj][m][0] * rsc, v1 = acc[ai][bj][m][1] * rsc;
                    if (SM == 2) { v0 = v0 * cs0[bj]; v1 = v1 * cs1[bj]; }
                    if (ACT == 1) { f32x2 a = gelu_pk((f32x2){v0[0], v0[1]}), b = gelu_pk((f32x2){v0[2], v0[3]}), c = gelu_pk((f32x2){v1[0], v1[1]}), d = gelu_pk((f32x2){v1[2], v1[3]});
                        v0 = (f32x4){a.x, a.y, b.x, b.y}; v1 = (f32x4){c.x, c.y, d.x, d.y}; }
                    u32x4 w; w.x = cvt_pk_bf16(v0[0], v0[1]); w.y = cvt_pk_bf16(v0[2], v0[3]); w.z = cvt_pk_bf16(v1[0], v1[1]); w.w = cvt_pk_bf16(v1[2], v1[3]);
                    *(u32x4*)(rowp + bj * HALF) = w; } }
    }
};
struct EpiSwiGLU {
    bf16_t* O; const float* rs;
    __device__ __forceinline__ void operator()(const f32x4 (&acc)[2][2][4][2], const Unit& u, int wr, int wc, int fr, int fq) const {
        bf16_t* base = O + (size_t)(u.pm * BM + wr * 64 + fr) * DFF + u.pn * 128 + wc * 32 + 8 * fq;
#pragma unroll
        for (int ai = 0; ai < 2; ++ai)
#pragma unroll
            for (int m = 0; m < 4; ++m) { bf16_t* rowp = base + (size_t)(ai * HALF + m * 16) * DFF; float r[8];
                const float rsc = rs[u.pm * BM + ai * HALF + wr * 64 + m * 16 + fr];
#pragma unroll
                for (int n = 0; n < 2; ++n)
#pragma unroll
                    for (int j = 0; j < 4; ++j) { const float g = acc[ai][0][m][n][j] * rsc, up = acc[ai][1][m][n][j] * rsc;
                        const float sg = g * __builtin_amdgcn_rcpf(1.0f + __builtin_amdgcn_exp2f(-1.4426950408889634f * g)); r[n * 4 + j] = sg * up; }
                u32x4 w; w.x = cvt_pk_bf16(r[0], r[1]); w.y = cvt_pk_bf16(r[2], r[3]); w.z = cvt_pk_bf16(r[4], r[5]); w.w = cvt_pk_bf16(r[6], r[7]);
                *(u32x4*)rowp = w; }
    }
};

template <class Epi, class Sched>
__device__ __forceinline__ void gemm_phase(const int tid, LAS unsigned char* lds, const bf16_t* Abase, const bf16_t* Bbase, const int lda, const int ldb, const int nt, const Sched& S, const Epi& E) {
    const int wid = __builtin_amdgcn_readfirstlane(tid >> 6), lane = tid & 63, wr = wid >> 2, wc = wid & 3, fr = lane & 15, fq = lane >> 4;
    unsigned voffA[2], voffB[2];
#pragma unroll
    for (int i = 0; i < 2; ++i) { int R, C; stage_rc(tid * 16 + i * 8192, R, C); const int Rb = (R & ~31) + perm32(R & 31);
        voffA[i] = (unsigned)(R * lda + C) * 2u; voffB[i] = (unsigned)(Rb * ldb + C) * 2u; }
    const size_t kstep = (size_t)(BK * 2);
    const size_t hstepA = (size_t)HALF * lda * 2, hstepB = (size_t)HALF * ldb * 2;
    const unsigned ldsw = (unsigned)wid * 1024u;
    const int aoff = lds_byte(wr * 64 + fr, fq * 8), boff = lds_byte(wc * 32 + fr, fq * 8);
#define PG8_SA(b, h) (((b) * 2 + (h)) * HTB)
#define PG8_SB(b, h) ((4 + (b) * 2 + (h)) * HTB)
#define PG8_STAGE(bufoff, gbase, voff) do { _Pragma("unroll") for (int _i = 0; _i < 2; ++_i) \
        __builtin_amdgcn_global_load_lds((const unsigned*)((const char*)(gbase) + (voff)[_i]), (LAS unsigned*)(lds + (bufoff) + ldsw + _i * 8192), 16, 0, 0); } while (0)
#define PG8_LDA(dst, b, h) do { _Pragma("unroll") for (int m = 0; m < 4; ++m) _Pragma("unroll") for (int k = 0; k < 2; ++k) dst[m][k] = *(const LAS bf16x8*)(lds + PG8_SA(b, h) + aoff + m * 2048 + k * 1024); } while (0)
#define PG8_LDB(dst, b, h) do { _Pragma("unroll") for (int n = 0; n < 2; ++n) _Pragma("unroll") for (int k = 0; k < 2; ++k) dst[n][k] = *(const LAS bf16x8*)(lds + PG8_SB(b, h) + boff + n * 2048 + k * 1024); } while (0)
#define PG8_MMA(ai, bj, At, Bt) do { __builtin_amdgcn_s_setprio(1); _Pragma("unroll") for (int m = 0; m < 4; ++m) _Pragma("unroll") for (int n = 0; n < 2; ++n) _Pragma("unroll") for (int k = 0; k < 2; ++k) \
        acc[ai][bj][m][n] = __builtin_amdgcn_mfma_f32_16x16x32_bf16(Bt[n][k], At[m][k], acc[ai][bj][m][n], 0, 0, 0); __builtin_amdgcn_s_setprio(0); } while (0)
#define PG8_WAIT_V(n) asm volatile("s_waitcnt vmcnt(" #n ")" ::: "memory")
#define PG8_WAIT_L(n) asm volatile("s_waitcnt lgkmcnt(" #n ")" ::: "memory")
#define PG8_BAR __builtin_amdgcn_s_barrier()
#define PG8_SCHED __builtin_amdgcn_sched_barrier(0)
    Unit cur, nxt; int ui = 0;
    if (!S.next(0, cur)) return;
    f32x4 acc[2][2][4][2];
#pragma unroll
    for (int a = 0; a < 2; ++a)
#pragma unroll
        for (int b = 0; b < 2; ++b)
#pragma unroll
            for (int m = 0; m < 4; ++m)
#pragma unroll
                for (int n = 0; n < 2; ++n) acc[a][b][m][n] = (f32x4){0.f, 0.f, 0.f, 0.f};
    bf16x8 At[4][2], B0[2][2], B1[2][2];
    const char* cA = (const char*)(Abase + cur.offA); const char* cB = (const char*)(Bbase + cur.offB);
    PG8_STAGE(PG8_SB(0, 0), cB, voffB); PG8_STAGE(PG8_SB(0, 1), cB + hstepB, voffB); PG8_STAGE(PG8_SA(0, 0), cA, voffA); PG8_STAGE(PG8_SA(0, 1), cA + hstepA, voffA);
    if (wr == 1) PG8_BAR;
    PG8_WAIT_V(2); PG8_BAR;
    PG8_STAGE(PG8_SB(1, 0), cB + kstep, voffB); PG8_STAGE(PG8_SA(1, 0), cA + kstep, voffA); PG8_STAGE(PG8_SB(1, 1), cB + hstepB + kstep, voffB);
    PG8_WAIT_V(6); PG8_BAR;
    for (;;) {
        const bool has_next = S.next(ui + 1, nxt);
        const char* nA = has_next ? (const char*)(Abase + nxt.offA) : cA; const char* nB = has_next ? (const char*)(Bbase + nxt.offB) : cB;
        for (int t = 0; t < nt; t += 2) {
            const bool last = (t == nt - 2);
            const char* a1 = cA + (size_t)(t + 1) * kstep;
            const char* a2 = last ? nA : cA + (size_t)(t + 2) * kstep; const char* b2 = last ? nB : cB + (size_t)(t + 2) * kstep;
            const char* a3 = a2 + kstep; const char* b3 = b2 + kstep;
            PG8_LDB(B0, 0, 0); PG8_LDB(B1, 0, 1); PG8_SCHED; PG8_LDA(At, 0, 0); PG8_STAGE(PG8_SA(1, 1), a1 + hstepA, voffA);
            PG8_WAIT_V(8); PG8_WAIT_L(0); PG8_BAR; PG8_MMA(0, 0, At, B0); PG8_MMA(0, 1, At, B1); PG8_BAR; PG8_SCHED;
            PG8_LDA(At, 0, 1); PG8_STAGE(PG8_SB(0, 0), b2, voffB); PG8_STAGE(PG8_SB(0, 1), b2 + hstepB, voffB); PG8_STAGE(PG8_SA(0, 0), a2, voffA);
            PG8_WAIT_V(8); PG8_WAIT_L(0); PG8_BAR; PG8_MMA(1, 0, At, B0); PG8_MMA(1, 1, At, B1); PG8_BAR; PG8_SCHED;
            PG8_LDB(B0, 1, 0); PG8_LDB(B1, 1, 1); PG8_SCHED; PG8_LDA(At, 1, 0); PG8_STAGE(PG8_SA(0, 1), a2 + hstepA, voffA);
            PG8_WAIT_V(8); PG8_WAIT_L(0); PG8_BAR; PG8_MMA(0, 0, At, B0); PG8_MMA(0, 1, At, B1); PG8_BAR; PG8_SCHED;
            PG8_LDA(At, 1, 1); PG8_STAGE(PG8_SB(1, 0), b3, voffB); PG8_STAGE(PG8_SB(1, 1), b3 + hstepB, voffB); PG8_STAGE(PG8_SA(1, 0), a3, voffA);
            PG8_WAIT_V(8); PG8_WAIT_L(0); PG8_BAR; PG8_MMA(1, 0, At, B0); PG8_MMA(1, 1, At, B1); PG8_BAR; PG8_SCHED;
        }
        if (wr == 0) PG8_BAR;
        { const int ln2 = lane_id_asm(); E(acc, cur, wr, wc, ln2 & 15, ln2 >> 4); }
        if (!has_next) break;
#pragma unroll
        for (int a = 0; a < 2; ++a)
#pragma unroll
            for (int b = 0; b < 2; ++b)
#pragma unroll
                for (int m = 0; m < 4; ++m)
#pragma unroll
                    for (int n = 0; n < 2; ++n) acc[a][b][m][n] = (f32x4){0.f, 0.f, 0.f, 0.f};
        cur = nxt; cA = nA; cB = nB; ++ui;
        if (wr == 1) PG8_BAR;
    }
    PG8_WAIT_V(0);
    PG8_BAR;
#undef PG8_SA
#undef PG8_SB
#undef PG8_STAGE
#undef PG8_LDA
#undef PG8_LDB
#undef PG8_MMA
#undef PG8_WAIT_V
#undef PG8_WAIT_L
#undef PG8_BAR
#undef PG8_SCHED
}
}

namespace att {
constexpr int AD = 128, NW = 8, QBLK = 32, KVBLK = 64;
constexpr float SCALE = 0.088388347648318440f;
constexpr float THR = 8.f;
constexpr size_t SHM_V = KVBLK * AD * 2, SHM_K = KVBLK * AD * 2, SHM_ATTN = 2 * SHM_V + 2 * SHM_K + NW * 64 * 4;
#define KSWZ(row, colB) ((row) * 256 + ((colB) ^ (((row) & 7) << 4)))
#define SBAR() __builtin_amdgcn_sched_barrier(0)
__device__ __forceinline__ int crow(int r, int hi) { return (r & 3) + 8 * (r >> 2) + 4 * hi; }
__device__ __forceinline__ unsigned cvtpk(float lo, float hi) { unsigned r; asm volatile("v_cvt_pk_bf16_f32 %0, %1, %2" : "=v"(r) : "v"(lo), "v"(hi)); return r; }
__device__ __forceinline__ void partialSM(f32x16& p0, f32x16& p1, float& m_reg, float& mn, float& alpha) {
  constexpr float C = SCALE * 1.4426950408889634f;
  float pmax = p0[0]; for (int r = 1; r < 16; ++r) pmax = fmaxf(pmax, p0[r]); for (int r = 0; r < 16; ++r) pmax = fmaxf(pmax, p1[r]);
  { auto rr = __builtin_amdgcn_permlane32_swap(__float_as_uint(pmax), __float_as_uint(pmax), false, false);
    pmax = fmaxf(__uint_as_float(rr[0]), __uint_as_float(rr[1])); }
  if (__builtin_expect(__all(pmax - m_reg <= THR / SCALE), 1)) { mn = m_reg; alpha = 1.f; }
  else { mn = fmaxf(m_reg, pmax); alpha = __builtin_amdgcn_exp2f((m_reg - mn) * C); m_reg = mn; }
  float mnC = -mn * C;
  for (int r = 0; r < 16; ++r) p0[r] = fmaf(p0[r], C, mnC); for (int r = 0; r < 16; ++r) p1[r] = fmaf(p1[r], C, mnC);
  for (int r = 0; r < 16; ++r) p0[r] = __builtin_amdgcn_exp2f(p0[r]);
}
__device__ __forceinline__ void finishSM(f32x16& p0, f32x16& p1, float alpha, float& l_reg, bf16x8& pa0, bf16x8& pa1, bf16x8& pa2, bf16x8& pa3) {
  for (int r = 0; r < 16; ++r) p1[r] = __builtin_amdgcn_exp2f(p1[r]);
  float ps = 0; for (int r = 0; r < 16; ++r) ps += p0[r]; for (int r = 0; r < 16; ++r) ps += p1[r];
  { auto rr = __builtin_amdgcn_permlane32_swap(__float_as_uint(ps), __float_as_uint(ps), false, false);
    ps = __uint_as_float(rr[0]) + __uint_as_float(rr[1]); }
  l_reg = l_reg * alpha + ps;
#define PK4(P, BASE, OUT) do { unsigned a0 = cvtpk(P[BASE + 0], P[BASE + 1]), a1 = cvtpk(P[BASE + 2], P[BASE + 3]);   \
    unsigned b0 = cvtpk(P[BASE + 4], P[BASE + 5]), b1 = cvtpk(P[BASE + 6], P[BASE + 7]);                              \
    auto r0 = __builtin_amdgcn_permlane32_swap(a0, b0, false, false); auto r1 = __builtin_amdgcn_permlane32_swap(a1, b1, false, false); \
    u32x4 w = {r0[0], r1[0], r0[1], r1[1]}; OUT = *reinterpret_cast<bf16x8*>(&w); } while (0)
  PK4(p0, 0, pa0); PK4(p0, 8, pa1); PK4(p1, 0, pa2); PK4(p1, 8, pa3);
#undef PK4
}
__device__ __forceinline__ void qkt(f32x16& p0, f32x16& p1, const bf16_t* Ks, const bf16x8* qr, int r32, int hi) {
  p0 = f32x16{}; p1 = f32x16{};
  for (int d0 = 0; d0 < 8; ++d0) { int cb = (d0 * 16 + hi * 8) * 2;
    bf16x8 b0 = *reinterpret_cast<const bf16x8*>((const char*)Ks + KSWZ(r32, cb));
    bf16x8 b1 = *reinterpret_cast<const bf16x8*>((const char*)Ks + KSWZ(32 + r32, cb));
    p0 = __builtin_amdgcn_mfma_f32_32x32x16_bf16(b0, qr[d0], p0, 0, 0, 0);
    p1 = __builtin_amdgcn_mfma_f32_32x32x16_bf16(b1, qr[d0], p1, 0, 0, 0); }
}
__device__ __forceinline__ int v_st(int k, int c) { const int kk = (k & ~0xC) | ((k & 4) << 1) | ((k & 8) >> 1); return ((kk >> 3) * 4 + (c >> 5)) * 512 + ((kk & 7) * 32 + (c & 31)) * 2; }
__device__ __forceinline__ int v_rd_base(int lane) { return ((lane & 3) << 3) | (((lane >> 2) & 3) << 6) | (((lane >> 4) & 1) << 5) | (((lane >> 5) & 1) << 8); }
constexpr int v_rd_off(int d0, int ks, int half) { return d0 * 512 + ks * 4096 + half * 2048; }
template <int OFF> __device__ __forceinline__ s16x4 tr_read(int vb) {
  s16x4 r; asm volatile("ds_read_b64_tr_b16 %0, %1 offset:%2" : "=&v"(r) : "v"(vb), "i"(OFF) : "memory"); return r;
}
template <int D0> __device__ __forceinline__ void pv_one(f32x16& od, int vb, bf16x8 pa0, bf16x8 pa1, bf16x8 pa2, bf16x8 pa3) {
  const s16x4 l0 = tr_read<v_rd_off(D0, 0, 0)>(vb), h0 = tr_read<v_rd_off(D0, 0, 1)>(vb), l1 = tr_read<v_rd_off(D0, 1, 0)>(vb), h1 = tr_read<v_rd_off(D0, 1, 1)>(vb);
  const s16x4 l2 = tr_read<v_rd_off(D0, 2, 0)>(vb), h2 = tr_read<v_rd_off(D0, 2, 1)>(vb), l3 = tr_read<v_rd_off(D0, 3, 0)>(vb), h3 = tr_read<v_rd_off(D0, 3, 1)>(vb);
  asm volatile("s_waitcnt lgkmcnt(0)" ::: "memory"); SBAR();
#define PK(L, H) (bf16x8){L[0], L[1], L[2], L[3], H[0], H[1], H[2], H[3]}
  od = __builtin_amdgcn_mfma_f32_32x32x16_bf16(pa0, PK(l0, h0), od, 0, 0, 0);
  od = __builtin_amdgcn_mfma_f32_32x32x16_bf16(pa1, PK(l1, h1), od, 0, 0, 0);
  od = __builtin_amdgcn_mfma_f32_32x32x16_bf16(pa2, PK(l2, h2), od, 0, 0, 0);
  od = __builtin_amdgcn_mfma_f32_32x32x16_bf16(pa3, PK(l3, h3), od, 0, 0, 0);
#undef PK
}
__device__ __forceinline__ void pv_d0(f32x16* o, int vb, bf16x8 pa0, bf16x8 pa1, bf16x8 pa2, bf16x8 pa3) {
  pv_one<0>(o[0], vb, pa0, pa1, pa2, pa3); pv_one<1>(o[1], vb, pa0, pa1, pa2, pa3); pv_one<2>(o[2], vb, pa0, pa1, pa2, pa3); pv_one<3>(o[3], vb, pa0, pa1, pa2, pa3);
}
template <int LDQ, int LDK, int LDO>
__device__ __forceinline__ void attn_dense_body(const int tid, const bf16_t* __restrict__ Qb, const bf16_t* __restrict__ Kh, const bf16_t* __restrict__ Vh, bf16_t* __restrict__ Ob, int seq, int rot, char* lds) {
  constexpr int SDEPTH = 2;
  const int wid = tid >> 6, lane = tid & 63, r32 = lane & 31, hi = lane >> 5;
  bf16_t* V_lds = (bf16_t*)lds; bf16_t* K_lds = (bf16_t*)(lds + 2 * SHM_V);
  float* ws = (float*)(lds + 2 * SHM_V + 2 * SHM_K) + wid * 64; float* li_l = ws; float* al_l = ws + 32;
  float m_reg = -1e30f, l_reg = 0; f32x16 o[4] = {}; bf16x8 qr[8];
  const bf16_t* Qw = Qb + (long)(wid * QBLK + r32) * LDQ + hi * 8;
#pragma unroll
  for (int d0 = 0; d0 < 8; ++d0) qr[d0] = *reinterpret_cast<const bf16x8*>(Qw + d0 * 16);
  const int sr = tid >> 4, sc = (tid & 15) * 8, vst0 = v_st(sr, sc), vst1 = v_st(32 + sr, sc);
  const int vb0 = (int)(uintptr_t)V_lds + v_rd_base(lane);
  struct { bf16x8 vs0, vs1, ks0, ks1; } sr_[SDEPTH];
#define LD8(p) (*reinterpret_cast<const bf16x8*>(p))
#define SLOAD(i, k0) do { sr_[i].vs0 = LD8(&Vh[(long)((k0) + sr) * LDK + sc]); sr_[i].vs1 = LD8(&Vh[(long)((k0) + 32 + sr) * LDK + sc]); \
    sr_[i].ks0 = LD8(&Kh[(long)((k0) + sr) * LDK + sc]); sr_[i].ks1 = LD8(&Kh[(long)((k0) + 32 + sr) * LDK + sc]); } while (0)
#define SWRITE(b, i) do { *(bf16x8*)((char*)V_lds + (b) * SHM_V + vst0) = sr_[i].vs0;          \
    *(bf16x8*)((char*)V_lds + (b) * SHM_V + vst1) = sr_[i].vs1; int kc = sc * 2;               \
    *(bf16x8*)((char*)K_lds + (b) * SHM_K + KSWZ(sr, kc)) = sr_[i].ks0;                       \
    *(bf16x8*)((char*)K_lds + (b) * SHM_K + KSWZ(32 + sr, kc)) = sr_[i].ks1; } while (0)
#define SWAIT() do { asm volatile("s_waitcnt vmcnt(4)" ::: "memory"); } while (0)
#define RESC(a) do { if (__any((a) < 1.f)) { if (hi == 0) al_l[r32] = (a); asm volatile("s_waitcnt lgkmcnt(0)" ::: "memory"); \
    for (int d = 0; d < 4; ++d) for (int r = 0; r < 16; ++r) o[d][r] *= al_l[crow(r, hi)]; } } while (0)
  f32x16 pA0, pA1, pB0, pB1; float mnA, mnB, alA, alB; bf16x8 pa0, pa1, pa2, pa3; const int NT = seq / KVBLK;
  const int ntm = NT - 1;
#define KT(t) ((((t) + rot) & ntm) * KVBLK)
  constexpr int SE = 0, SO = SDEPTH - 1;
  SLOAD(SE, KT(0)); asm volatile("s_waitcnt vmcnt(0)" ::: "memory"); SWRITE(0, SE); __syncthreads();
  qkt(pA0, pA1, K_lds, qr, r32, hi); partialSM(pA0, pA1, m_reg, mnA, alA);
  SLOAD(SO, KT(1)); if (2 < NT) SLOAD(SE, KT(2));
  SWAIT(); SWRITE(1, SO); __syncthreads();
  for (int j = 1; j + 1 < NT; j += 2) {
    SBAR(); qkt(pB0, pB1, (bf16_t*)((char*)K_lds + SHM_K), qr, r32, hi);
    finishSM(pA0, pA1, alA, l_reg, pa0, pa1, pa2, pa3); SBAR();
    SLOAD(SO, KT(j + SDEPTH)); SBAR();
    pv_d0(o, vb0, pa0, pa1, pa2, pa3); partialSM(pB0, pB1, m_reg, mnB, alB);
    __syncthreads(); SWAIT(); SWRITE(0, SE);
    RESC(alB); __syncthreads();
    SBAR(); qkt(pA0, pA1, K_lds, qr, r32, hi);
    finishSM(pB0, pB1, alB, l_reg, pa0, pa1, pa2, pa3); SBAR();
    if (j + 3 < NT) SLOAD(SE, KT(j + 1 + SDEPTH)); SBAR();
    pv_d0(o, vb0 + (int)SHM_V, pa0, pa1, pa2, pa3); partialSM(pA0, pA1, m_reg, mnA, alA);
    __syncthreads(); SWAIT(); SWRITE(1, SO);
    RESC(alA); __syncthreads();
  }
  SBAR(); qkt(pB0, pB1, (bf16_t*)((char*)K_lds + SHM_K), qr, r32, hi);
  finishSM(pA0, pA1, alA, l_reg, pa0, pa1, pa2, pa3); SBAR();
  pv_d0(o, vb0, pa0, pa1, pa2, pa3); partialSM(pB0, pB1, m_reg, mnB, alB);
  __syncthreads(); RESC(alB);
  finishSM(pB0, pB1, alB, l_reg, pa0, pa1, pa2, pa3); SBAR();
  pv_d0(o, vb0 + (int)SHM_V, pa0, pa1, pa2, pa3);
  if (hi == 0) li_l[r32] = l_reg; asm volatile("s_waitcnt lgkmcnt(0)" ::: "memory");
  float rli[16];
#pragma unroll
  for (int r = 0; r < 16; ++r) rli[r] = __builtin_amdgcn_rcpf(li_l[crow(r, hi)]);
  bf16_t* Ow = Ob + (long)(wid * QBLK) * LDO;
#pragma unroll
  for (int r = 0; r < 16; ++r) { int orow = crow(r, hi);
    for (int d0 = 0; d0 < 4; ++d0) Ow[(long)orow * LDO + d0 * 32 + r32] = (bf16_t)f2bf(o[d0][r] * rli[r]); }
#undef KT
#undef LD8
#undef SLOAD
#undef SWRITE
#undef SWAIT
#undef RESC
}
}

namespace att2 {
using namespace att;
constexpr int KST = 16384, VST = 32768;
constexpr int V_OFF = 2 * KST;
constexpr int SCR_OFF = 133120;
template <int OFF> __device__ __forceinline__ bf16x8 lds_read128(int addr) { bf16x8 r; asm volatile("ds_read_b128 %0, %1 offset:%2" : "=&v"(r) : "v"(addr), "i"(OFF) : "memory"); return r; }
#define A2_WAIT_L(n) asm volatile("s_waitcnt lgkmcnt(" #n ")" ::: "memory")
__device__ __forceinline__ void qkt_l(f32x16& p0, f32x16& p1, const int kb, const int hx, const bf16x8* qr) {
  p0 = f32x16{}; p1 = f32x16{};
  bf16x8 c0 = lds_read128<0>(kb + hx), c1 = lds_read128<8192>(kb + hx);
#pragma unroll
  for (int d0 = 0; d0 < 8; ++d0) { bf16x8 n0 = c0, n1 = c1;
    if (d0 < 7) { const int a = kb + (((d0 + 1) << 5) ^ hx); n0 = lds_read128<0>(a); n1 = lds_read128<8192>(a); A2_WAIT_L(2); } else { A2_WAIT_L(0); }
    SBAR();
    p0 = __builtin_amdgcn_mfma_f32_32x32x16_bf16(c0, qr[d0], p0, 0, 0, 0);
    p1 = __builtin_amdgcn_mfma_f32_32x32x16_bf16(c1, qr[d0], p1, 0, 0, 0);
    c0 = n0; c1 = n1; }
}
template <int BLK> __device__ __forceinline__ void pv_read8(s16x4 (&f)[8], int vb) {
  constexpr int B0 = (BLK >> 2) * 16384 + (BLK & 3) * 512;
  f[0] = tr_read<B0>(vb); f[1] = tr_read<B0 + 2048>(vb); f[2] = tr_read<B0 + 4096>(vb); f[3] = tr_read<B0 + 4096 + 2048>(vb);
  f[4] = tr_read<B0 + 8192>(vb); f[5] = tr_read<B0 + 8192 + 2048>(vb); f[6] = tr_read<B0 + 12288>(vb); f[7] = tr_read<B0 + 12288 + 2048>(vb);
}
__device__ __forceinline__ void pv_mma(f32x16& od, const s16x4 (&f)[8], bf16x8 pa0, bf16x8 pa1, bf16x8 pa2, bf16x8 pa3) {
#define PK(L, H) (bf16x8){L[0], L[1], L[2], L[3], H[0], H[1], H[2], H[3]}
  od = __builtin_amdgcn_mfma_f32_32x32x16_bf16(pa0, PK(f[0], f[1]), od, 0, 0, 0);
  od = __builtin_amdgcn_mfma_f32_32x32x16_bf16(pa1, PK(f[2], f[3]), od, 0, 0, 0);
  od = __builtin_amdgcn_mfma_f32_32x32x16_bf16(pa2, PK(f[4], f[5]), od, 0, 0, 0);
  od = __builtin_amdgcn_mfma_f32_32x32x16_bf16(pa3, PK(f[6], f[7]), od, 0, 0, 0);
#undef PK
}
__device__ __forceinline__ void pv_pipe(f32x16* o, int vb, bf16x8 pa0, bf16x8 pa1, bf16x8 pa2, bf16x8 pa3) {
  s16x4 fa[8], fb[8];
  pv_read8<0>(fa, vb);
  pv_read8<1>(fb, vb); A2_WAIT_L(8); SBAR(); pv_mma(o[0], fa, pa0, pa1, pa2, pa3); SBAR();
  pv_read8<2>(fa, vb); A2_WAIT_L(8); SBAR(); pv_mma(o[1], fb, pa0, pa1, pa2, pa3); SBAR();
  pv_read8<3>(fb, vb); A2_WAIT_L(8); SBAR(); pv_mma(o[2], fa, pa0, pa1, pa2, pa3); SBAR();
  pv_read8<4>(fa, vb); A2_WAIT_L(8); SBAR(); pv_mma(o[3], fb, pa0, pa1, pa2, pa3); SBAR();
  pv_read8<5>(fb, vb); A2_WAIT_L(8); SBAR(); pv_mma(o[4], fa, pa0, pa1, pa2, pa3); SBAR();
  pv_read8<6>(fa, vb); A2_WAIT_L(8); SBAR(); pv_mma(o[5], fb, pa0, pa1, pa2, pa3); SBAR();
  pv_read8<7>(fb, vb); A2_WAIT_L(8); SBAR(); pv_mma(o[6], fa, pa0, pa1, pa2, pa3); SBAR();
  A2_WAIT_L(0); SBAR(); pv_mma(o[7], fb, pa0, pa1, pa2, pa3);
}
template <int LDQ, int LDK, int LDO>
__device__ __forceinline__ void attn256_body(const int tid, const bf16_t* __restrict__ Qb, const bf16_t* __restrict__ Kh, const bf16_t* __restrict__ Vh, bf16_t* __restrict__ Ob, const int seq, LAS unsigned char* lds) {
  const int wid = __builtin_amdgcn_readfirstlane(tid >> 6), lane = tid & 63, r32 = lane & 31, hi = lane >> 5;
  const bool grpB = wid >= 4;
  LAS float* ws = (LAS float*)(lds + SCR_OFF) + wid * 64; LAS float* li_l = ws; LAS float* al_l = ws + 32;
  float m_reg = -1e30f, l_reg = 0; f32x16 o[8] = {}; bf16x8 qr[8];
  const bf16_t* Qw = Qb + (long)(wid * QBLK + r32) * LDQ + hi * 8;
#pragma unroll
  for (int d0 = 0; d0 < 8; ++d0) qr[d0] = *reinterpret_cast<const bf16x8*>(Qw + d0 * 16);
  unsigned koff[2], voff[2][2];
#pragma unroll
  for (int i = 0; i < 2; ++i) { const int ob = i * 8192 + wid * 1024 + lane * 16;
    { const int row = ob >> 8, cb = ob & 255; koff[i] = (unsigned)(row * LDK * 2 + (cb ^ ((row & 7) << 4))); }
    { const int sub = ob >> 9, kkhi = sub >> 2, cblk = sub & 3, w_ = (ob & 511) >> 1, kk = kkhi * 8 + (w_ >> 5), c = cblk * 32 + (w_ & 31);
      const int k = (kk & ~0xC) | ((kk & 4) << 1) | ((kk & 8) >> 1);
      voff[0][i] = (unsigned)(k * LDK * 2 + c * 2); voff[1][i] = voff[0][i] + 256u; } }
  const unsigned ldsw = (unsigned)wid * 1024u;
  const int vrb = (int)(uintptr_t)lds + V_OFF + v_rd_base(lane);
  const int krb = (int)(uintptr_t)lds + r32 * 256, hx = (hi * 16) ^ ((r32 & 7) << 4);
#define A2_ISSUE(t, ks, vs) do { const char* kb_ = (const char*)Kh + (size_t)(t) * (KVBLK * LDK * 2); const char* vb_ = (const char*)Vh + (size_t)(t) * (KVBLK * LDK * 2); \
    _Pragma("unroll") for (int i_ = 0; i_ < 2; ++i_) { \
      __builtin_amdgcn_global_load_lds((const unsigned*)(kb_ + koff[i_]), (LAS unsigned*)(lds + (ks) * KST + i_ * 8192 + ldsw), 16, 0, 0); \
      __builtin_amdgcn_global_load_lds((const unsigned*)(vb_ + voff[0][i_]), (LAS unsigned*)(lds + V_OFF + (vs) * VST + i_ * 8192 + ldsw), 16, 0, 0); \
      __builtin_amdgcn_global_load_lds((const unsigned*)(vb_ + voff[1][i_]), (LAS unsigned*)(lds + V_OFF + (vs) * VST + 16384 + i_ * 8192 + ldsw), 16, 0, 0); } } while (0)
#define A2_PV(vs) pv_pipe(o, vrb + (vs) * VST, pa0, pa1, pa2, pa3)
  const int NT = seq / KVBLK;
  bf16x8 pa0, pa1, pa2, pa3;
  A2_ISSUE(0, 0, 0);
  int vs = 0, vsp = 2;
  for (int t = 0; t < NT; ++t) {
    asm volatile("s_waitcnt vmcnt(0)" ::: "memory"); __builtin_amdgcn_s_barrier(); asm volatile("" ::: "memory");
    const int vsn = (vs == 2) ? 0 : vs + 1;
    if (t + 1 < NT) A2_ISSUE(t + 1, (t + 1) & 1, vsn);
    if (grpB && t > 0) A2_PV(vsp);
    f32x16 p0, p1; float mn, alpha;
    qkt_l(p0, p1, krb + (t & 1) * KST, hx, qr);
    partialSM(p0, p1, m_reg, mn, alpha);
    if (__any(alpha < 1.f)) { if (hi == 0) al_l[r32] = alpha; asm volatile("s_waitcnt lgkmcnt(0)" ::: "memory");
#pragma unroll
      for (int d = 0; d < 8; ++d)
#pragma unroll
        for (int r = 0; r < 16; ++r) o[d][r] *= al_l[crow(r, hi)]; }
    finishSM(p0, p1, alpha, l_reg, pa0, pa1, pa2, pa3); SBAR();
    if (!grpB) A2_PV(vs);
    vsp = vs; vs = vsn;
  }
  if (grpB) A2_PV(vsp);
#undef A2_ISSUE
#undef A2_PV
#undef A2_WAIT_L
  if (hi == 0) li_l[r32] = l_reg; asm volatile("s_waitcnt lgkmcnt(0)" ::: "memory");
  float rli[16];
#pragma unroll
  for (int r = 0; r < 16; ++r) rli[r] = __builtin_amdgcn_rcpf(li_l[crow(r, hi)]);
  __builtin_amdgcn_s_barrier(); asm volatile("" ::: "memory");
  bf16_t* Ow = Ob + (long)(wid * QBLK) * LDO;
#pragma unroll
  for (int r = 0; r < 16; ++r) { const int orow = crow(r, hi);
#pragma unroll
    for (int d0 = 0; d0 < 8; ++d0) Ow[(long)orow * LDO + d0 * 32 + r32] = (bf16_t)f2bf(o[d0][r] * rli[r]); }
}
}

#define XB_TMO      128
#define XB_XCNT(j)  (256  + 64 * (j))
#define XB_XSUB(j)  (1280 + 64 * (j))
#define XB_XGEN(j)  (2304 + 64 * (j))
#define XB_TOP      3328
#define XB_TOPGEN   3392
#define XCD_BAR_WORDS 3456
#define XB_SPIN_CAP (1u << 18)
__device__ __forceinline__ unsigned xb_ld(unsigned* p)              { return __hip_atomic_load(p, __ATOMIC_RELAXED, __HIP_MEMORY_SCOPE_AGENT); }
__device__ __forceinline__ unsigned xb_add(unsigned* p, unsigned v) { return __hip_atomic_fetch_add(p, v, __ATOMIC_RELAXED, __HIP_MEMORY_SCOPE_AGENT); }
__device__ __forceinline__ unsigned xb_xcc_id() { return (unsigned)__builtin_amdgcn_s_getreg((3 << 11) | 20) & 0xFu; }
#define XB_SPIN(cond, bar) do { unsigned _sp = 0; while (cond) { __builtin_amdgcn_s_sleep(1); \
    if ((++_sp & 255u) == 0u) { if (xb_ld(&(bar)[XB_TMO])) break; if (_sp > XB_SPIN_CAP) { atomicAdd(&(bar)[XB_TMO], 1u); break; } } } } while (0)
struct XcdBarrier { unsigned* bar; unsigned x; volatile LAS unsigned* st; };
__device__ __forceinline__ XcdBarrier xcd_barrier_post(unsigned* bar, volatile LAS unsigned* st) {
    XcdBarrier b; b.bar = bar; b.x = xb_xcc_id(); b.st = st;
    if (threadIdx.x == 0) (void)xb_add(&bar[XB_XCNT(b.x)], 1u);
    return b;
}
__device__ __forceinline__ void xcd_barrier_complete(unsigned* bar, unsigned x, unsigned& nloc, unsigned& nx) {
    const unsigned G = gridDim.x * gridDim.y * gridDim.z;
    unsigned sum, cnt, mine, sp = 0u;
    for (;;) {
        sum = 0u; cnt = 0u; mine = 0u;
#pragma unroll
        for (unsigned j = 0; j < 16; ++j) { const unsigned c = xb_ld(&bar[XB_XCNT(j)]); sum += c; cnt += (c > 0u) ? 1u : 0u; mine = (j == x) ? c : mine; }
        if (sum == G) break;
        __builtin_amdgcn_s_sleep(1);
        if ((++sp & 255u) == 0u) { if (xb_ld(&bar[XB_TMO])) break; if (sp > XB_SPIN_CAP) { atomicAdd(&bar[XB_TMO], 1u); break; } }
    }
    nloc = mine > 0u ? mine : 1u; nx = cnt > 0u ? cnt : 1u;
}
__device__ __forceinline__ void xcd_barrier(const XcdBarrier& b) {
    asm volatile("s_waitcnt vmcnt(0)" ::: "memory");
    __syncthreads();
    if (threadIdx.x == 0) {
        unsigned* bar = b.bar;
        __builtin_amdgcn_s_waitcnt(0);
        unsigned nloc = b.st[0], nx = b.st[1];
        if (nloc == 0u) { xcd_barrier_complete(bar, b.x, nloc, nx); b.st[0] = nloc; b.st[1] = nx; }
        const unsigned old = xb_add(&bar[XB_XSUB(b.x)], 1u);
        const unsigned gen = old / nloc;
        if (old + 1u == (gen + 1u) * nloc) {
            __builtin_amdgcn_fence(__ATOMIC_RELEASE, "agent");
            asm volatile("s_waitcnt vmcnt(0)" ::: "memory");
            const unsigned og = xb_add(&bar[XB_TOP], 1u);
            const unsigned tg = og / nx;
            if (og + 1u == (tg + 1u) * nx) xb_add(&bar[XB_TOPGEN], 1u);
            else XB_SPIN(xb_ld(&bar[XB_TOPGEN]) == tg, bar);
            __builtin_amdgcn_fence(__ATOMIC_ACQUIRE, "agent");
            xb_add(&bar[XB_XGEN(b.x)], 1u);
            asm volatile("s_waitcnt vmcnt(0)" ::: "memory");
        } else {
            XB_SPIN(xb_ld(&bar[XB_XGEN(b.x)]) == gen, bar);
            __builtin_amdgcn_fence(__ATOMIC_ACQUIRE, "agent");
            asm volatile("s_waitcnt vmcnt(0)" ::: "memory");
        }
    }
    __syncthreads();
}

__device__ __forceinline__ void transpose_item(const float* W, int K, int N, bf16_t* WT, int mode, const float* gk, LAS float* scr, int item, int lane) {
    const int nblk = N / 32, kb = item / nblk, nb = item % nblk, k0 = 64 * kb, n0 = 32 * nb;
    const int r0 = mode == 0 ? n0 : ((n0 >> 7) * 256 + (n0 & 127) + (mode == 2 ? 128 : 0));
#pragma unroll 8
    for (int i = 0; i < 32; ++i) { const int kk = 2 * i + (lane >> 5); const float gv = gk ? gk[k0 + kk] : 1.0f; scr[kk * 33 + (lane & 31)] = W[(size_t)(k0 + kk) * N + n0 + (lane & 31)] * gv; }
    LDS_WAIT(); asm volatile("" ::: "memory");
    const int c = lane & 7;
#pragma unroll
    for (int j = 0; j < 4; ++j) { const int n = (lane >> 3) + 8 * j; const LAS float* s = scr + (8 * c) * 33 + n;
        u32x4 o; o.x = cvt_pk_bf16(s[0 * 33], s[1 * 33]); o.y = cvt_pk_bf16(s[2 * 33], s[3 * 33]); o.z = cvt_pk_bf16(s[4 * 33], s[5 * 33]); o.w = cvt_pk_bf16(s[6 * 33], s[7 * 33]);
        *(GAS u32x4*)(WT + (size_t)(r0 + n) * K + k0 + 8 * c) = o; }
    LDS_WAIT(); asm volatile("" ::: "memory");
}
__device__ __forceinline__ void transpose_matrix(const float* W, int K, int N, bf16_t* WT, int mode, const float* gk, LAS float* scr, int gw, int NGW, int lane, int& base) {
    const int n = (K / 64) * (N / 32);
    int first = (gw - base % NGW + NGW) % NGW;
    for (int it = first; it < n; it += NGW) transpose_item(W, K, N, WT, mode, gk, scr, it, lane);
    base += n;
}
__device__ __forceinline__ void convert_ffn_weights(const float* Wg, const float* Wu, const float* Wd, const float* gk, bf16_t* W1, bf16_t* WD, LAS float* scr, int gw, int NGW, int lane) {
    int base = 0;
    transpose_matrix(Wg, D, DFF, W1, 1, gk, scr, gw, NGW, lane, base);
    transpose_matrix(Wu, D, DFF, W1, 2, gk, scr, gw, NGW, lane, base);
    transpose_matrix(Wd, DFF, D, WD, 0, nullptr, scr, gw, NGW, lane, base);
}

template <bool FIRST, bool LAST>
__device__ __forceinline__ void rowpass(const float* xp, const float* xs, bf16_t* xb, float* xout, const bf16_t* f, float* rstd, const float* gpost, float scale, int gw, int NGW, int lane) {
    f32x4 gp[4][2];
#pragma unroll
    for (int j = 0; j < 4; ++j) { gp[j][0] = FIRST ? (f32x4){0.f, 0.f, 0.f, 0.f} : *(const f32x4*)(gpost + 512 * j + 8 * lane); gp[j][1] = FIRST ? (f32x4){0.f, 0.f, 0.f, 0.f} : *(const f32x4*)(gpost + 512 * j + 8 * lane + 4); }
    for (int row = gw; row < NTOK; row += NGW) {
        f32x4 x[4][2];
        if (FIRST) { const float* xrow = row < NPROMPT ? xp + (size_t)row * D : xs + (size_t)(row - NPROMPT) * D;
#pragma unroll
            for (int j = 0; j < 4; ++j) { x[j][0] = *(const GAS f32x4*)(xrow + 512 * j + 8 * lane); x[j][1] = *(const GAS f32x4*)(xrow + 512 * j + 8 * lane + 4); }
        } else {
            u32x4 xv[4], fv[4];
#pragma unroll
            for (int j = 0; j < 4; ++j) { xv[j] = *(const GAS u32x4*)(xb + (size_t)row * D + 512 * j + 8 * lane); fv[j] = *(const GAS u32x4*)(f + (size_t)row * D + 512 * j + 8 * lane); }
            float ss = 0.f; f32x4 ff[4][2];
#pragma unroll
            for (int j = 0; j < 4; ++j) { ff[j][0] = (f32x4){bf_lo(fv[j].x), bf_hi(fv[j].x), bf_lo(fv[j].y), bf_hi(fv[j].y)}; ff[j][1] = (f32x4){bf_lo(fv[j].z), bf_hi(fv[j].z), bf_lo(fv[j].w), bf_hi(fv[j].w)};
                x[j][0] = (f32x4){bf_lo(xv[j].x), bf_hi(xv[j].x), bf_lo(xv[j].y), bf_hi(xv[j].y)}; x[j][1] = (f32x4){bf_lo(xv[j].z), bf_hi(xv[j].z), bf_lo(xv[j].w), bf_hi(xv[j].w)};
#pragma unroll
                for (int h = 0; h < 2; ++h) ss += (ff[j][h].x * ff[j][h].x + ff[j][h].y * ff[j][h].y) + (ff[j][h].z * ff[j][h].z + ff[j][h].w * ff[j][h].w); }
            const float r = rsqrtf(wave_sum(ss, lane) * (1.0f / D) + 1e-6f) * scale;
#pragma unroll
            for (int j = 0; j < 4; ++j) { x[j][0] = x[j][0] + ff[j][0] * r * gp[j][0]; x[j][1] = x[j][1] + ff[j][1] * r * gp[j][1]; }
        }
        if (LAST) {
#pragma unroll
            for (int j = 0; j < 4; ++j) { *(GAS f32x4*)(xout + (size_t)row * D + 512 * j + 8 * lane) = x[j][0]; *(GAS f32x4*)(xout + (size_t)row * D + 512 * j + 8 * lane + 4) = x[j][1]; }
        } else {
            float s2 = 0.f;
#pragma unroll
            for (int j = 0; j < 4; ++j) { u32x4 w; w.x = cvt_pk_bf16(x[j][0].x, x[j][0].y); w.y = cvt_pk_bf16(x[j][0].z, x[j][0].w); w.z = cvt_pk_bf16(x[j][1].x, x[j][1].y); w.w = cvt_pk_bf16(x[j][1].z, x[j][1].w);
                *(GAS u32x4*)(xb + (size_t)row * D + 512 * j + 8 * lane) = w;
#pragma unroll
                for (int h = 0; h < 2; ++h) s2 += (x[j][h].x * x[j][h].x + x[j][h].y * x[j][h].y) + (x[j][h].z * x[j][h].z + x[j][h].w * x[j][h].w); }
            const float r2 = rsqrtf(wave_sum(s2, lane) * (1.0f / D) + 1e-6f);
            if (lane == 0) rstd[row] = r2;
        }
    }
}

__device__ __forceinline__ void sincos_d(double x, double& s, double& c) {
    const double n = rint(x * 0.63661977236758134308);
    double r = x - n * 1.57079632679489655800e+00; r = r - n * 6.12323399573676603587e-17;
    const long long q = (long long)n;
    const double r2 = r * r;
    double sp = -7.6471637318198164759e-13;
    sp = sp * r2 + 1.6059043836821614599e-10; sp = sp * r2 - 2.5052108385441718775e-08; sp = sp * r2 + 2.7557319223985890653e-06; sp = sp * r2 - 1.9841269841269841270e-04;
    sp = sp * r2 + 8.3333333333333333333e-03; sp = sp * r2 - 1.6666666666666666667e-01; const double sr = r + r * r2 * sp;
    double cp = 4.7794773323873852974e-14;
    cp = cp * r2 - 1.1470745597729724714e-11; cp = cp * r2 + 2.0876756987868098979e-09; cp = cp * r2 - 2.7557319223985890653e-07; cp = cp * r2 + 2.4801587301587301587e-05;
    cp = cp * r2 - 1.3888888888888888889e-03; cp = cp * r2 + 4.1666666666666666667e-02; cp = cp * r2 - 0.5; const double cr = 1.0 + r2 * cp;
    const int qq = (int)(q & 3);
    s = (qq == 0) ? sr : (qq == 1) ? cr : (qq == 2) ? -sr : -cr;
    c = (qq == 0) ? cr : (qq == 1) ? -sr : (qq == 2) ? -cr : sr;
}

struct Args { const float* in[27]; float* out; unsigned char* ws; int ph_lo, ph_hi; };
static_assert(sizeof(Args) == 29 * 8 + 8, "Args has no padding");

__host__ __device__ constexpr int mixer_phases(int kind) { return kind == 1 ? 4 : (kind == 0 ? 3 : 2); }
__host__ __device__ constexpr int total_phases() {
    int n = 2;
    for (int l = 0; l < NLAYER; ++l) n += 3 + mixer_phases(l % 3) + 2 + 4 + 3;
    return n;
}

typedef const __attribute__((address_space(4))) Args* KArgsP;
__global__ void __launch_bounds__(NTHREADS, 2) trunk_fwd(Args args) {
    extern __shared__ __attribute__((aligned(16))) unsigned char lds_raw[];
    LAS unsigned char* const lds = (LAS unsigned char*)lds_raw;
    volatile LAS unsigned* const MISC = (volatile LAS unsigned*)(lds + MISC_OFF);
    const int G = gridDim.x, bx = blockIdx.x;
    const int vcu = (G % 8 == 0) ? (bx % 8) * (G / 8) + bx / 8 : bx;
    const int NGW = G * NWAVES;
    const int wave_s = __builtin_amdgcn_readfirstlane((int)threadIdx.x >> 6);
    for (int u = threadIdx.x; u < (LDS_BYTES - RING_BYTES) / 4; u += NTHREADS) ((LAS unsigned*)(lds + RING_BYTES))[u] = 0u;
    __syncthreads();
    const int lo = args.ph_lo, hi = args.ph_hi;
    if (hi - lo > 1) (void)xcd_barrier_post((unsigned*)(args.ws + WS_CTL) + CW_BAR, MISC + 8);

    int ph = 0;
    unsigned long long pr_acc = 0, pr_prev = PROBE_T ? __builtin_amdgcn_s_memrealtime() : 0ull;
#define PH_BEGIN(kind) if (ph >= lo && ph < hi) { \
        KArgsP ap = (KArgsP)__builtin_amdgcn_kernarg_segment_ptr(); asm volatile("" : "+s"(ap)); \
        const int wave = wave_s; const int tid = wave_s * 64 + lane_id_asm(); \
        const int lane = tid & 63; const int gw = vcu * NWAVES + wave; \
        unsigned char* const ws = ap->ws; (void)lane; (void)gw; (void)ws;
#define PH_END(kind) } if (ph >= lo && ph + 1 < hi) { KArgsP ap2 = (KArgsP)__builtin_amdgcn_kernarg_segment_ptr(); asm volatile("" : "+s"(ap2)); \
        XcdBarrier b_; b_.bar = (unsigned*)(ap2->ws + WS_CTL) + CW_BAR; b_.x = xb_xcc_id(); b_.st = MISC + 8; xcd_barrier(b_); } ++ph; \
        if (PROBE_T) { const unsigned long long tn_ = __builtin_amdgcn_s_memrealtime(); if ((PROBE_T >> (kind)) & 1) pr_acc += tn_ - pr_prev; pr_prev = tn_; }
#define WSP(T, OFF) ((T*)(ws + (OFF)))

    PH_BEGIN(0)
        LAS float* scr = (LAS float*)(lds + wave * 16384);
        const float* a_w_in = ap->in[10]; const float* a_w_out = ap->in[15]; const float* ln_pre = ap->in[4];
        int base = 0;
        for (int s = 0; s < 2; ++s) transpose_matrix(a_w_in + (size_t)s * D * 4096, D, 4096, WSP(bf16_t, WS_AWIN) + (size_t)s * 4096 * D, 0, ln_pre + (size_t)(3 * s * 4 + 1) * D, scr, gw, NGW, lane, base);
        for (int s = 0; s < 2; ++s) transpose_matrix(a_w_out + (size_t)s * D * D, D, D, WSP(bf16_t, WS_AWOUT) + (size_t)s * D * D, 0, nullptr, scr, gw, NGW, lane, base);
        transpose_matrix(ap->in[16], D, 6144, WSP(bf16_t, WS_BWQKV), 0, ln_pre + (size_t)(1 * 4 + 1) * D, scr, gw, NGW, lane, base);
        transpose_matrix(ap->in[22], D, D, WSP(bf16_t, WS_BWOUT), 0, nullptr, scr, gw, NGW, lane, base);
        transpose_matrix(ap->in[23], D, D, WSP(bf16_t, WS_CWOUT), 0, nullptr, scr, gw, NGW, lane, base);
        for (int l = 0; l < NLAYER; ++l) {
            transpose_matrix(ap->in[24] + (size_t)l * D * 512, D, 512, WSP(bf16_t, WS_XWQ) + (size_t)l * 512 * D, 0, ln_pre + (size_t)(l * 4 + 2) * D, scr, gw, NGW, lane, base);
            transpose_matrix(ap->in[25] + (size_t)l * D * 1024, D, 1024, WSP(bf16_t, WS_XWKV) + (size_t)l * 1024 * D, 0, nullptr, scr, gw, NGW, lane, base);
            transpose_matrix(ap->in[26] + (size_t)l * 512 * D, 512, D, WSP(bf16_t, WS_XWOUT) + (size_t)l * D * 512, 0, nullptr, scr, gw, NGW, lane, base);
        }
        convert_ffn_weights(ap->in[7], ap->in[8], ap->in[9], ln_pre, WSP(bf16_t, WS_W1), WSP(bf16_t, WS_WD), scr, gw, NGW, lane);
        rowpass<true, false>(ap->in[0], ap->in[1], WSP(bf16_t, WS_H), nullptr, nullptr, WSP(float, WS_RSTD), nullptr, 1.f, gw, NGW, lane);
        { const float* mem_prompt = ap->in[2]; const float* mem_sample = ap->in[3]; const float* ln_mem = ap->in[6]; bf16_t* MEMN = WSP(bf16_t, WS_MEMN);
        for (int idx = gw; idx < NLAYER * NMEMTOK; idx += NGW) { const int l = idx / NMEMTOK, r = idx % NMEMTOK;
            const float* src = r < 256 ? mem_prompt + (size_t)r * D : mem_sample + (size_t)(r - 256) * D;
            const GAS f32x4* xr = (const GAS f32x4*)src + lane; f32x4 x[8]; float s2 = 0.f;
#pragma unroll
            for (int j = 0; j < 8; ++j) { x[j] = xr[64 * j]; s2 += (x[j].x * x[j].x + x[j].y * x[j].y) + (x[j].z * x[j].z + x[j].w * x[j].w); }
            const float r2 = rsqrtf(wave_sum(s2, lane) * (1.0f / D) + 1e-6f);
            GAS u32x2* ho = (GAS u32x2*)(MEMN + ((size_t)l * NMEMTOK + r) * D) + lane;
#pragma unroll
            for (int j = 0; j < 8; ++j) { const f32x4 g = *(const f32x4*)(ln_mem + l * D + 256 * j + 4 * lane); const f32x4 v = x[j] * r2 * g; u32x2 w; w.x = cvt_pk_bf16(v.x, v.y); w.y = cvt_pk_bf16(v.z, v.w); ho[64 * j] = w; } } }
        { float* ropeC = WSP(float, WS_ROPE_COS); float* ropeS = WSP(float, WS_ROPE_SIN); bf16_t* csT = WSP(bf16_t, WS_CS); bf16_t* wspT = WSP(bf16_t, WS_WSP); const float* a_w_s = ap->in[13];
        const float* gF = ln_pre + (size_t)(2 * 4 + 1) * D;
        const int gt = vcu * NTHREADS + tid, NGT = G * NTHREADS;
        for (int idx = gt; idx < 8192 * 16; idx += NGT) { const int pos = idx >> 4, j = idx & 15;
            const float invf = (float)exp(-13.122363377404328 * (double)j * 0.0625);
            const float ang = (float)pos * invf; double s, c; sincos_d((double)ang, s, c); ropeC[idx] = (float)c; ropeS[idx] = (float)s; }
        for (int idx = gt; idx < 8 * 512 * 256; idx += NGT) { const int g = idx >> 17, lp = (idx >> 8) & 511, cch = idx & 255, l = lp & 255; const float fr = (float)((l * cch) & 255) * (1.0f / 256.0f);
            csT[idx] = (bf16_t)f2bf((lp < 256 ? __builtin_amdgcn_cosf(fr) : __builtin_amdgcn_sinf(fr)) * gF[g * 256 + cch]); }
        for (int idx = gt; idx < 2 * 8 * 128 * 128; idx += NGT) wspT[idx] = (bf16_t)f2bf(a_w_s[idx]); }
    PH_END(0)

    PH_BEGIN(1)
        pg8::BatchOrder S; S.nM = 9; S.nN = 4; S.nZ = NLAYER; S.G = G; S.c = bx; S.ldc = 1024;
        S.sAm = (size_t)256 * D; S.sAz = (size_t)NMEMTOK * D; S.sBn = (size_t)256 * D; S.sBz = (size_t)1024 * D; S.sCm = (size_t)256 * 1024; S.sCn = 256; S.sCz = (size_t)NMEMTOK * 1024;
        pg8::EpiBf16<0, 0> E{WSP(bf16_t, WS_KV), 1.f, nullptr};
        pg8::gemm_phase(tid, lds, WSP(bf16_t, WS_MEMN), WSP(bf16_t, WS_XWKV), D, D, D / 64, S, E);
    PH_END(1)

    for (int hl = 0; hl < 2 * NLAYER; ++hl) {
        const int layer = hl >> 1, which = hl & 1;
        PH_BEGIN(2)
            pg8::StdOrder S; S.init(NTOK, 2 * DFF, D, D, DFF, G, bx);
            pg8::EpiSwiGLU E{WSP(bf16_t, WS_A), WSP(float, WS_RSTD)};
            PREP(1) pg8::gemm_phase(tid, lds, WSP(bf16_t, WS_H), WSP(bf16_t, WS_W1), D, D, D / 64, S, E);
        PH_END(2)
        PH_BEGIN(3)
            pg8::StdOrder S; S.init(NTOK, D, DFF, DFF, D, G, bx);
            pg8::EpiBf16<0, 0> E{WSP(bf16_t, WS_B), 1.f, nullptr};
            PREP(2) pg8::gemm_phase(tid, lds, WSP(bf16_t, WS_A), WSP(bf16_t, WS_WD), DFF, DFF, DFF / 64, S, E);
        PH_END(3)
        PH_BEGIN(4)
            const float* ln_pre = ap->in[4]; const float* ln_post = ap->in[5];
            const float* gpost = ln_post + (size_t)(layer * 4 + (which ? 3 : 0)) * D;
            if (hl == 2 * NLAYER - 1) rowpass<false, true>(nullptr, nullptr, WSP(bf16_t, WS_H), ap->out, WSP(bf16_t, WS_B), nullptr, gpost, 0.5f, gw, NGW, lane);
            else {
                rowpass<false, false>(nullptr, nullptr, WSP(bf16_t, WS_H), nullptr, WSP(bf16_t, WS_B), WSP(float, WS_RSTD), gpost, 0.5f, gw, NGW, lane);
                const size_t wo = (size_t)(hl + 1) * D * DFF; const int l2 = (hl + 1) >> 1, w2 = (hl + 1) & 1;
                PREP(4) convert_ffn_weights(ap->in[7] + wo, ap->in[8] + wo, ap->in[9] + wo, ln_pre + (size_t)(l2 * 4 + (w2 ? 3 : 0)) * D, WSP(bf16_t, WS_W1), WSP(bf16_t, WS_WD), (LAS float*)(lds + wave * 16384), gw, NGW, lane); }
        PH_END(4)
        if (which == 0) {
            const int kind = layer % 3, slot = layer / 3;
            if (kind == 0) {
                PH_BEGIN(5)
                    pg8::StdOrder S; S.init(NTOK, 4096, D, D, 4096, G, bx);
                    pg8::EpiBf16<1, 1> E{WSP(bf16_t, WS_A), 1.f, WSP(float, WS_RSTD)};
                    PREP(9) pg8::gemm_phase(tid, lds, WSP(bf16_t, WS_H), WSP(bf16_t, WS_AWIN) + (size_t)slot * 4096 * D, D, D, D / 64, S, E);
                PH_END(5)
                PH_BEGIN(6)
                    const bf16_t* RA = WSP(bf16_t, WS_A); f32x2* vstats = WSP(f32x2, WS_STATS);
                    PREP(7) for (int row = gw; row < NTOK; row += NGW) {
                        const GAS u32x4* vr = (const GAS u32x4*)(RA + (size_t)row * 4096 + 2048) + lane; u32x4 v[4]; float s = 0.f;
#pragma unroll
                        for (int j = 0; j < 4; ++j) { v[j] = vr[64 * j]; s += (bf_lo(v[j].x) + bf_hi(v[j].x)) + (bf_lo(v[j].y) + bf_hi(v[j].y)) + (bf_lo(v[j].z) + bf_hi(v[j].z)) + (bf_lo(v[j].w) + bf_hi(v[j].w)); }
                        const float mean = wave_sum(s, lane) * (1.0f / 2048.0f); float q = 0.f;
#pragma unroll
                        for (int j = 0; j < 4; ++j) { const unsigned w4[4] = {v[j].x, v[j].y, v[j].z, v[j].w};
#pragma unroll
                            for (int k = 0; k < 4; ++k) { const float a = bf_lo(w4[k]) - mean, b = bf_hi(w4[k]) - mean; q += a * a + b * b; } }
                        const float rstd = rsqrtf(wave_sum(q, lane) * (1.0f / 2048.0f) + 1e-5f);
                        if (lane == 0) vstats[row] = (f32x2){mean, rstd};
                    }
                PH_END(6)
                PH_BEGIN(7)
                    using namespace att;
                    const bf16_t* RA = WSP(bf16_t, WS_A); bf16_t* MX = WSP(bf16_t, WS_B); const f32x2* vstats = WSP(f32x2, WS_STATS); const bf16_t* wspT = WSP(bf16_t, WS_WSP);
                    const float* a_b_s = ap->in[14];
                    const int r32 = lane & 31, hi2 = lane >> 5, pb = wave & 3, ch = wave >> 2;
                    const int sr = tid >> 4, sc = (tid & 15) * 8, vst0 = v_st(sr, sc), vst1 = v_st(32 + sr, sc);
                    const int vb0 = (int)(uintptr_t)(lds_raw) + v_rd_base(lane);
                    const float* lng = ap->in[11] + (size_t)slot * 2048; const float* lnb = ap->in[12] + (size_t)slot * 2048;
                    PREP(7) for (int un = vcu; un < 320 * 8; un += G) {
                        const int g = un & 7, ck = un >> 3; const int tok0 = ck * 128;
                        __syncthreads();
#pragma unroll
                        for (int hc = 0; hc < 2; ++hc) {
                            const int gc = g * 256 + hc * 128 + sc;
                            const f32x4 g0 = *(const f32x4*)(lng + gc), g1 = *(const f32x4*)(lng + gc + 4), b0 = *(const f32x4*)(lnb + gc), b1 = *(const f32x4*)(lnb + gc + 4);
#pragma unroll
                            for (int kt = 0; kt < 2; ++kt)
#pragma unroll
                                for (int rr = 0; rr < 2; ++rr) { const int q = kt * 64 + rr * 32 + sr; const int tok = tok0 + q;
                                    const u32x4 raw = *(const GAS u32x4*)(RA + (size_t)tok * 4096 + 2048 + gc); const f32x2 st = vstats[tok];
                                    f32x4 a = (f32x4){bf_lo(raw.x), bf_hi(raw.x), bf_lo(raw.y), bf_hi(raw.y)}, b = (f32x4){bf_lo(raw.z), bf_hi(raw.z), bf_lo(raw.w), bf_hi(raw.w)};
                                    a = (a - st.x) * st.y * g0 + b0; b = (b - st.x) * st.y * g1 + b1;
                                    u32x4 w; w.x = cvt_pk_bf16(a.x, a.y); w.y = cvt_pk_bf16(a.z, a.w); w.z = cvt_pk_bf16(b.x, b.y); w.w = cvt_pk_bf16(b.z, b.w);
                                    *(LAS u32x4*)(lds + (kt * 2 + hc) * 16384 + (rr ? vst1 : vst0)) = w; }
                        }
                        bf16x8 pa[2][4];
                        const bf16_t* wrow = wspT + ((size_t)(slot * 8 + g) * 128 + 32 * pb + r32) * 128 + 8 * hi2;
#pragma unroll
                        for (int kt = 0; kt < 2; ++kt)
#pragma unroll
                            for (int i = 0; i < 4; ++i) pa[kt][i] = *(const bf16x8*)(wrow + kt * 64 + 16 * i);
                        __syncthreads();
                        f32x16 o[4] = {};
                        pv_d0(o, vb0 + (0 * 2 + ch) * 16384, pa[0][0], pa[0][1], pa[0][2], pa[0][3]);
                        pv_d0(o, vb0 + (1 * 2 + ch) * 16384, pa[1][0], pa[1][1], pa[1][2], pa[1][3]);
#pragma unroll
                        for (int r = 0; r < 16; ++r) { const int p = 32 * pb + crow(r, hi2); const int tok = tok0 + p; const float bias = a_b_s[(size_t)(slot * 8 + g) * 128 + p];
#pragma unroll
                            for (int d0 = 0; d0 < 4; ++d0) { const int c = g * 256 + ch * 128 + d0 * 32 + r32;
                                const float uu = bf_lo((unsigned)RA[(size_t)tok * 4096 + c]);
                                MX[(size_t)tok * D + c] = (bf16_t)f2bf(uu * (o[d0][r] + bias)); } }
                    }
                    __syncthreads();
                PH_END(7)
            } else if (kind == 1) {
                PH_BEGIN(8)
                    pg8::StdOrder S; S.init(NTOK, 6144, D, D, 6144, G, bx);
                    pg8::EpiBf16<0, 1> E{WSP(bf16_t, WS_A), 1.f, WSP(float, WS_RSTD)};
                    PREP(9) pg8::gemm_phase(tid, lds, WSP(bf16_t, WS_H), WSP(bf16_t, WS_BWQKV), D, D, D / 64, S, E);
                PH_END(8)
                PH_BEGIN(9)
                    bf16_t* RA = WSP(bf16_t, WS_A); const float* ropeC = WSP(float, WS_ROPE_COS); const float* ropeS = WSP(float, WS_ROPE_SIN);
                    const int v = lane >> 1, half = lane & 1;
                    const int colbase = (v < 16 ? v * 128 : 2048 + (v - 16) * 128) + 8 * half;
                    for (int row = gw; row < NTOK; row += NGW) {
                        const int pos = row < NPROMPT ? row : (row & (SSAMP - 1));
                        GAS u32x4* p1 = (GAS u32x4*)(RA + (size_t)row * 6144 + colbase); GAS u32x4* p2 = (GAS u32x4*)(RA + (size_t)row * 6144 + colbase + 16);
                        const u32x4 a = *p1, b = *p2;
                        const f32x4 c0 = *(const f32x4*)(ropeC + pos * 16 + 8 * half), c1 = *(const f32x4*)(ropeC + pos * 16 + 8 * half + 4), s0 = *(const f32x4*)(ropeS + pos * 16 + 8 * half), s1 = *(const f32x4*)(ropeS + pos * 16 + 8 * half + 4);
                        const float x1[8] = {bf_lo(a.x), bf_hi(a.x), bf_lo(a.y), bf_hi(a.y), bf_lo(a.z), bf_hi(a.z), bf_lo(a.w), bf_hi(a.w)};
                        const float x2[8] = {bf_lo(b.x), bf_hi(b.x), bf_lo(b.y), bf_hi(b.y), bf_lo(b.z), bf_hi(b.z), bf_lo(b.w), bf_hi(b.w)};
                        const float cc[8] = {c0.x, c0.y, c0.z, c0.w, c1.x, c1.y, c1.z, c1.w}, sn[8] = {s0.x, s0.y, s0.z, s0.w, s1.x, s1.y, s1.z, s1.w};
                        float o1[8], o2[8];
#pragma unroll
                        for (int j = 0; j < 8; ++j) { o1[j] = x1[j] * cc[j] - x2[j] * sn[j]; o2[j] = x2[j] * cc[j] + x1[j] * sn[j]; }
                        *p1 = (u32x4){cvt_pk_bf16(o1[0], o1[1]), cvt_pk_bf16(o1[2], o1[3]), cvt_pk_bf16(o1[4], o1[5]), cvt_pk_bf16(o1[6], o1[7])};
                        *p2 = (u32x4){cvt_pk_bf16(o2[0], o2[1]), cvt_pk_bf16(o2[2], o2[3]), cvt_pk_bf16(o2[4], o2[5]), cvt_pk_bf16(o2[6], o2[7])};
                    }
                PH_END(9)
                PH_BEGIN(10)
                    const bf16_t* RA = WSP(bf16_t, WS_A); bf16_t* RB = WSP(bf16_t, WS_B);
                    PREP(5) for (int idx = vcu; idx < 2560; idx += G) {
                        int h16, qb, seq; size_t t0;
                        if (idx < 512) { const int i = idx >> 8, w = idx & 255; h16 = (w >> 5) * 2 + i; qb = w & 31; t0 = 0; seq = NPROMPT; }
                        else { const int id2 = idx - 512, r = id2 >> 8, w = id2 & 255; const int b = w >> 5, jj = w & 31; h16 = 2 * r + (jj >> 4); qb = jj & 15; t0 = (size_t)NPROMPT + (size_t)b * SSAMP; seq = SSAMP; }
                        const bf16_t* Q = RA + (t0 + qb * 256) * 6144 + h16 * 128; const bf16_t* K = RA + t0 * 6144 + 2048 + h16 * 128; const bf16_t* V = RA + t0 * 6144 + 4096 + (h16 >> 1) * 256;
                        bf16_t* O = RB + (size_t)(h16 & 1) * NTOK * D + (t0 + qb * 256) * D + (h16 >> 1) * 256;
                        const int tid2 = wave * 64 + lane_id_asm();
                        att2::attn256_body<6144, 6144, 2048>(tid2, Q, K, V, O, seq, lds); }
                    __syncthreads();
                PH_END(10)
                PH_BEGIN(11)
                    const float* b_lq1 = ap->in[17]; const float* b_lk1 = ap->in[18]; const float* b_lq2 = ap->in[19]; const float* b_lk2 = ap->in[20]; const float* b_subln = ap->in[21];
                    const float lam_init = 0.8f - 0.6f * expf(-0.3f * (float)layer);
                    float d1 = b_lq1[lane] * b_lk1[lane] + b_lq1[lane + 64] * b_lk1[lane + 64], d2 = b_lq2[lane] * b_lk2[lane] + b_lq2[lane + 64] * b_lk2[lane + 64];
                    const float lam = expf(wave_sum(d1, lane)) - expf(wave_sum(d2, lane)) + lam_init;
                    const f32x4 sg = *(const f32x4*)(b_subln + 4 * lane); const float osc = 1.0f - lam_init;
                    const bf16_t* O0 = WSP(bf16_t, WS_B); const bf16_t* O1 = O0 + (size_t)NTOK * D; bf16_t* CO = WSP(bf16_t, WS_A);
                    for (int row = gw; row < NTOK; row += NGW) {
                        const GAS u32x2* p0 = (const GAS u32x2*)(O0 + (size_t)row * D) + lane; const GAS u32x2* p1 = (const GAS u32x2*)(O1 + (size_t)row * D) + lane;
                        GAS u32x2* po = (GAS u32x2*)(CO + (size_t)row * D) + lane;
                        u32x2 a[8], b[8];
#pragma unroll
                        for (int j = 0; j < 8; ++j) { a[j] = p0[64 * j]; b[j] = p1[64 * j]; }
#pragma unroll
                        for (int j = 0; j < 8; ++j) { f32x4 dv = (f32x4){bf_lo(a[j].x) - lam * bf_lo(b[j].x), bf_hi(a[j].x) - lam * bf_hi(b[j].x), bf_lo(a[j].y) - lam * bf_lo(b[j].y), bf_hi(a[j].y) - lam * bf_hi(b[j].y)};
                            const float ss = wave_sum((dv.x * dv.x + dv.y * dv.y) + (dv.z * dv.z + dv.w * dv.w), lane); const float r = rsqrtf(ss * (1.0f / 256.0f) + 1e-5f) * osc;
                            dv = dv * r * sg; u32x2 w; w.x = cvt_pk_bf16(dv.x, dv.y); w.y = cvt_pk_bf16(dv.z, dv.w); po[64 * j] = w; }
                    }
                PH_END(11)
            } else {
                PH_BEGIN(12)
                    {
                        bf16_t* Tp = WSP(bf16_t, WS_B); bf16_t* Ts = Tp + (size_t)8192 * 16384;
                        const long gt = (long)vcu * NTHREADS + tid, NGT = (long)G * NTHREADS;
                        for (long it = gt; it < (long)8192 * 2048; it += NGT) { const int k = (int)(it >> 11), c8 = (int)(it & 2047), part = c8 >> 10, s0 = (c8 & 1023) * 8; unsigned w[4];
#pragma unroll
                            for (int e = 0; e < 4; ++e) { const float f0 = (float)((k * (s0 + 2 * e)) & 8191) * (1.0f / 8192.0f), f1 = (float)((k * (s0 + 2 * e + 1)) & 8191) * (1.0f / 8192.0f);
                                const float v0 = part ? -__builtin_amdgcn_sinf(f0) : __builtin_amdgcn_cosf(f0), v1 = part ? -__builtin_amdgcn_sinf(f1) : __builtin_amdgcn_cosf(f1); w[e] = cvt_pk_bf16(v0, v1); }
                            *(GAS u32x4*)(Tp + (size_t)k * 16384 + part * 8192 + s0) = (u32x4){w[0], w[1], w[2], w[3]}; }
                        for (long it = gt; it < (long)4096 * 1024; it += NGT) { const int k = (int)(it >> 10), c8 = (int)(it & 1023), part = c8 >> 9, s0 = (c8 & 511) * 8; unsigned w[4];
#pragma unroll
                            for (int e = 0; e < 4; ++e) { const float f0 = (float)((k * (s0 + 2 * e)) & 4095) * (1.0f / 4096.0f), f1 = (float)((k * (s0 + 2 * e + 1)) & 4095) * (1.0f / 4096.0f);
                                const float v0 = part ? -__builtin_amdgcn_sinf(f0) : __builtin_amdgcn_cosf(f0), v1 = part ? -__builtin_amdgcn_sinf(f1) : __builtin_amdgcn_cosf(f1); w[e] = cvt_pk_bf16(v0, v1); }
                            *(GAS u32x4*)(Ts + (size_t)k * 8192 + part * 4096 + s0) = (u32x4){w[0], w[1], w[2], w[3]}; }
                    }
                    pg8::F1Order S; S.G = G; S.c = bx;
                    pg8::EpiBf16<0, 2> E{WSP(bf16_t, WS_A), 1.f, WSP(float, WS_RSTD)};
                    int nt4 = 4; asm volatile("" : "+s"(nt4));
                    pg8::gemm_phase(tid, lds, WSP(bf16_t, WS_CS), WSP(bf16_t, WS_H), 256, D, nt4, S, E);
                PH_END(12)
                PH_BEGIN(13)
                    bf16_t* Y = WSP(bf16_t, WS_A + 320 * MiB);
                    {   pg8::StdOrder S; S.init(NPROMPT, D, 16384, 16384, D, G, bx);
                        pg8::EpiBf16<0, 0> E{Y, 6.9053396600248786e-04f, nullptr};
                        pg8::gemm_phase(tid, lds, WSP(bf16_t, WS_B), WSP(bf16_t, WS_A), 16384, 16384, 256, S, E); }
                    {   pg8::BatchOrder S; S.nM = 16; S.nN = 8; S.nZ = 8; S.G = G; S.c = bx; S.ldc = D;
                        S.sAm = (size_t)256 * 8192; S.sAz = 0; S.sBn = (size_t)256 * 8192; S.sBz = (size_t)2048 * 8192; S.sCm = (size_t)256 * D; S.sCn = 256; S.sCz = (size_t)SSAMP * D;
                        pg8::EpiBf16<0, 0> E{Y + (size_t)NPROMPT * D, 9.765625e-04f, nullptr};
                        pg8::gemm_phase(tid, lds, WSP(bf16_t, WS_B) + (size_t)8192 * 16384, WSP(bf16_t, WS_A) + (size_t)2048 * 16384, 8192, 8192, 128, S, E); }
                PH_END(13)
            }
            PH_BEGIN(14)
                const bf16_t* WOT = kind == 0 ? WSP(bf16_t, WS_AWOUT) + (size_t)slot * D * D : (kind == 1 ? WSP(bf16_t, WS_BWOUT) : WSP(bf16_t, WS_CWOUT));
                const bf16_t* MXI = kind == 0 ? WSP(bf16_t, WS_B) : (kind == 1 ? WSP(bf16_t, WS_A) : WSP(bf16_t, WS_A + 320 * MiB));
                pg8::StdOrder S; S.init(NTOK, D, D, D, D, G, bx);
                pg8::EpiBf16<0, 0> E{kind == 1 ? WSP(bf16_t, WS_B) : WSP(bf16_t, WS_A), 1.f, nullptr};
                PREP(9) pg8::gemm_phase(tid, lds, MXI, WOT, D, D, D / 64, S, E);
            PH_END(14)
            PH_BEGIN(15)
                rowpass<false, false>(nullptr, nullptr, WSP(bf16_t, WS_H), nullptr, kind == 1 ? WSP(bf16_t, WS_B) : WSP(bf16_t, WS_A), WSP(float, WS_RSTD), ap->in[5] + (size_t)(layer * 4 + 1) * D, 1.0f, gw, NGW, lane);
            PH_END(15)
            PH_BEGIN(16)
                pg8::StdOrder S; S.init(NTOK, 512, D, D, 512, G, bx);
                pg8::EpiBf16<0, 1> E{WSP(bf16_t, WS_A), 1.f, WSP(float, WS_RSTD)};
                PREP(9) pg8::gemm_phase(tid, lds, WSP(bf16_t, WS_H), WSP(bf16_t, WS_XWQ) + (size_t)layer * 512 * D, D, D, D / 64, S, E);
            PH_END(16)
            PH_BEGIN(17)
                const bf16_t* QX = WSP(bf16_t, WS_A); bf16_t* OX = WSP(bf16_t, WS_A) + (size_t)NTOK * 512;
                const bf16_t* KVl = WSP(bf16_t, WS_KV) + (size_t)layer * NMEMTOK * 1024;
                PREP(8) for (int idx = vcu; idx < 640; idx += G) { const int tb = idx >> 2, head = idx & 3; const int bm = tb < 32 ? 0 : 1 + ((tb - 32) >> 4);
                    const bf16_t* Q = QX + (size_t)tb * 256 * 512 + head * 128; const bf16_t* K = KVl + (size_t)bm * 256 * 1024 + head * 128; const bf16_t* V = K + 512;
                    bf16_t* O = OX + (size_t)tb * 256 * 512 + head * 128;
                    const int tid2 = wave * 64 + lane_id_asm();
                    att::attn_dense_body<512, 1024, 512>(tid2, Q, K, V, O, 256, 0, (char*)lds_raw); __syncthreads(); }
            PH_END(17)
            PH_BEGIN(18)
                pg8::StdOrder S; S.init(NTOK, D, 512, 512, D, G, bx);
                pg8::EpiBf16<0, 0> E{WSP(bf16_t, WS_A) + (size_t)NTOK * 1024, 1.f, nullptr};
                PREP(9) pg8::gemm_phase(tid, lds, WSP(bf16_t, WS_A) + (size_t)NTOK * 512, WSP(bf16_t, WS_XWOUT) + (size_t)layer * D * 512, 512, 512, 8, S, E);
            PH_END(18)
            PH_BEGIN(19)
                rowpass<false, false>(nullptr, nullptr, WSP(bf16_t, WS_H), nullptr, WSP(bf16_t, WS_A) + (size_t)NTOK * 1024, WSP(float, WS_RSTD), ap->in[5] + (size_t)(layer * 4 + 2) * D, 1.0f, gw, NGW, lane);
            PH_END(19)
        }
    }
    if (PROBE_T && bx == 0) { const unsigned long long t0_ = __builtin_amdgcn_s_memrealtime(); while (__builtin_amdgcn_s_memrealtime() - t0_ < PROBE_AMP * pr_acc) __builtin_amdgcn_s_sleep(8); }
#undef PH_BEGIN
#undef PH_END
#undef WSP
}

extern "C" void kernel_launch(void* const* d_in, const int* in_sizes, int n_in, void* d_out, int out_size, void* d_ws, size_t ws_size, hipStream_t stream) {
    static int grid = 0;
    if (grid == 0) {
        if (n_in != 27 || out_size != NTOK * D || ws_size < WS_END) { fprintf(stderr, "kernel_launch: unexpected shapes: n_in %d out %d ws %zu (need %zu)\n", n_in, out_size, ws_size, (size_t)WS_END); grid = -1; return; }
        int dev = 0, cus = 0, per_cu = 0;
        if (hipGetDevice(&dev) != hipSuccess || hipDeviceGetAttribute(&cus, hipDeviceAttributeMultiprocessorCount, dev) != hipSuccess) { grid = -1; return; }
        if (hipFuncSetAttribute((const void*)trunk_fwd, hipFuncAttributeMaxDynamicSharedMemorySize, LDS_BYTES) != hipSuccess) { fprintf(stderr, "kernel_launch: hipFuncSetAttribute failed\n"); grid = -1; return; }
        if (hipOccupancyMaxActiveBlocksPerMultiprocessor(&per_cu, (const void*)trunk_fwd, NTHREADS, LDS_BYTES) != hipSuccess || per_cu < 1) fprintf(stderr, "kernel_launch: occupancy query reports %d\n", per_cu);
        (void)hipGetLastError();
        grid = cus;
    }
    if (grid < 0) return;
    (void)hipMemsetAsync((char*)d_ws + WS_CTL, 0, CTL_ZERO_BYTES, stream);
    Args a{};
    for (int i = 0; i < 27; ++i) a.in[i] = (const float*)d_in[i];
    a.out = (float*)d_out; a.ws = (unsigned char*)d_ws;
    constexpr int NPH = total_phases();
#if MK_PER_PHASE
    for (int p = 0; p < NPH; ++p) { a.ph_lo = p; a.ph_hi = p + 1; hipLaunchKernelGGL(trunk_fwd, dim3(grid), dim3(NTHREADS), LDS_BYTES, stream, a); }
#else
    a.ph_lo = 0; a.ph_hi = NPH; hipLaunchKernelGGL(trunk_fwd, dim3(grid), dim3(NTHREADS), LDS_BYTES, stream, a);
#endif
    const hipError_t le = hipPeekAtLastError();
    if (le != hipSuccess) fprintf(stderr, "kernel_launch: launch failed: %s\n", hipGetErrorName(le));
}
```

```cpp
#include <hip/hip_runtime.h>
#include <cstdio>
#include <cstdint>

#ifndef PROBE_ID
#define PROBE_ID 0
#endif
#ifndef PROBE_T
#define PROBE_T 0
#endif
#define PROBE_AMP 4
#define PREP(k) for (int rep_ = 0; rep_ < ((PROBE_ID == (k)) ? 2 : 1); ++rep_)
#ifndef PG8_XCD_REMAP
#define PG8_XCD_REMAP 0
#endif
#ifndef PG8_WGM
#define PG8_WGM 8
#endif
#ifndef MK_PER_PHASE
#define MK_PER_PHASE 0
#endif

#define LAS __attribute__((address_space(3)))
#define GAS __attribute__((address_space(1)))
typedef unsigned short bf16_t;
typedef short bf16x8 __attribute__((ext_vector_type(8)));
typedef short s16x4 __attribute__((ext_vector_type(4)));
typedef float f32x2 __attribute__((ext_vector_type(2)));
typedef float f32x4 __attribute__((ext_vector_type(4)));
typedef float f32x16 __attribute__((ext_vector_type(16)));
typedef unsigned u32x2 __attribute__((ext_vector_type(2)));
typedef unsigned u32x4 __attribute__((ext_vector_type(4)));

constexpr int D = 2048, NTOK = 40960, NPROMPT = 8192, SSAMP = 4096, DFF = 5504, NMEMTOK = 2304, NLAYER = 4;
constexpr int NWAVES = 8, NTHREADS = 512;

constexpr size_t MiB = 1u << 20;
constexpr size_t WS_CTL = 0, CTL_ZERO_BYTES = 1 * MiB;
constexpr size_t WS_ROPE_COS = 1 * MiB, WS_ROPE_SIN = WS_ROPE_COS + 512 * 1024;
constexpr size_t WS_WSP = 2 * MiB;
constexpr size_t WS_STATS = 2 * MiB + 512 * 1024;
constexpr size_t WS_RSTD = 3 * MiB;
constexpr size_t WS_KV = 4 * MiB;
constexpr size_t WS_MEMN = 22 * MiB;
constexpr size_t WS_AWIN = 58 * MiB;
constexpr size_t WS_AWOUT = 90 * MiB;
constexpr size_t WS_BWQKV = 106 * MiB;
constexpr size_t WS_BWOUT = 130 * MiB;
constexpr size_t WS_CWOUT = 138 * MiB;
constexpr size_t WS_XWQ = 146 * MiB;
constexpr size_t WS_XWKV = 154 * MiB;
constexpr size_t WS_XWOUT = 170 * MiB;
constexpr size_t WS_W1 = 178 * MiB;
constexpr size_t WS_WD = 221 * MiB;
constexpr size_t WS_H = 244 * MiB;
constexpr size_t WS_A = 404 * MiB;
constexpr size_t WS_B = 884 * MiB;
constexpr size_t WS_CS = 1204 * MiB;
constexpr size_t WS_END = 1206 * MiB;
constexpr int CW_BAR = 4096;

constexpr int RING_BYTES = 131072;
constexpr int MISC_OFF = RING_BYTES + 320;
constexpr int LDS_BYTES = 147456;

__device__ __forceinline__ unsigned f2bf(float f) { unsigned u = __builtin_bit_cast(unsigned, f); return (u + 0x7fffu + ((u >> 16) & 1u)) >> 16; }
__device__ __forceinline__ unsigned cvt_pk_bf16(float lo, float hi) { unsigned r; asm volatile("v_cvt_pk_bf16_f32 %0, %1, %2" : "=v"(r) : "v"(lo), "v"(hi)); return r; }
__device__ __forceinline__ float bf_lo(unsigned w) { return __builtin_bit_cast(float, w << 16); }
__device__ __forceinline__ float bf_hi(unsigned w) { return __builtin_bit_cast(float, w & 0xffff0000u); }
__device__ __forceinline__ float wave_sum(float v, int lane) {
#pragma unroll
    for (int o = 1; o < 64; o <<= 1) v += __builtin_bit_cast(float, __builtin_amdgcn_ds_bpermute((lane ^ o) << 2, __builtin_bit_cast(int, v)));
    return v;
}
__device__ __forceinline__ int lane_id_asm() { int l; asm volatile("v_mbcnt_lo_u32_b32 %0, -1, 0\n\tv_mbcnt_hi_u32_b32 %0, -1, %0" : "=v"(l)); return l; }
#define LDS_WAIT() asm volatile("s_waitcnt lgkmcnt(0)" ::: "memory")
#define VM_WAIT() asm volatile("s_waitcnt vmcnt(0)" ::: "memory")

namespace pg8 {
constexpr int BM = 256, BK = 64, HALF = 128, HTB = HALF * BK * 2, STAGE_BYTES = 8 * HTB, NXCD = 8, WGM = PG8_WGM;
__host__ __device__ __forceinline__ int lds_byte(int r, int c) { const int st = (r >> 4) * 2 + (c >> 5), rr = r & 15, cc = c & 31, ob = rr * 64 + cc * 2; return st * 1024 + (ob ^ (((ob >> 9) & 1) << 5)); }
__host__ __device__ __forceinline__ void stage_rc(int b, int& R, int& C) { const int st = b / 1024, sb = b % 1024, swz = sb ^ (((sb >> 9) & 1) << 5); R = (st >> 1) * 16 + swz / 64; C = (st & 1) * 32 + (swz % 64) / 2; }
__host__ __device__ __forceinline__ int perm32(int rho) { const int n = rho >> 4, i = rho & 15; return 8 * (i >> 2) + 4 * n + (i & 3); }

struct Unit { int pm, pn, z, ldc; size_t offA, offB, offC; };

struct StdOrder {
    int nM, nN, nwg, G, c, ldc; size_t sA, sB, sCm, sCn;
    __device__ void init(int M, int N, int lda, int ldb, int ldc_, int G_, int c_, int cn = 256) { nM = M / BM; nN = N / BM; nwg = nM * nN; G = G_; c = c_; ldc = ldc_; sA = (size_t)BM * lda; sB = (size_t)BM * ldb; sCm = (size_t)BM * ldc_; sCn = (size_t)cn; }
    __device__ __forceinline__ bool next(int i, Unit& u) const {
        const long L = (long)i * G + c; if (L >= nwg) return false;
        int wgid = (int)L;
#if PG8_XCD_REMAP
        { const int q = nwg / NXCD, r = nwg % NXCD, xcd = wgid % NXCD, off = wgid / NXCD; wgid = (xcd < r ? xcd * (q + 1) : r * (q + 1) + (xcd - r) * q) + off; }
#endif
        const int nig = WGM * nN, gid = wgid / nig, fm = gid * WGM, gsz = (nM - fm) < WGM ? (nM - fm) : WGM;
        u.pm = fm + ((wgid % nig) % gsz); u.pn = (wgid % nig) / gsz; u.z = 0; u.ldc = ldc;
        u.offA = (size_t)u.pm * sA; u.offB = (size_t)u.pn * sB; u.offC = (size_t)u.pm * sCm + (size_t)u.pn * sCn; return true;
    }
};
struct BatchOrder {
    int nM, nN, nZ, G, c, ldc; size_t sAm, sAz, sBn, sBz, sCm, sCn, sCz;
    __device__ __forceinline__ bool next(int i, Unit& u) const {
        const long L = (long)i * G + c; const int per = nM * nN; if (L >= (long)per * nZ) return false;
        const int z = (int)(L / per), r = (int)(L % per); u.z = z; u.pm = r % nM; u.pn = r / nM; u.ldc = ldc;
        u.offA = (size_t)u.pm * sAm + (size_t)z * sAz; u.offB = (size_t)u.pn * sBn + (size_t)z * sBz; u.offC = (size_t)u.pm * sCm + (size_t)u.pn * sCn + (size_t)z * sCz; return true;
    }
};
struct F1Order {
    int G, c;
    __device__ __forceinline__ bool next(int i, Unit& u) const {
        const long L = (long)i * G + c; if (L >= 2560) return false;
        const int g = (int)(L / 320), r = (int)(L % 320); u.z = g; u.pm = r & 1; u.pn = r >> 1;
        u.offA = (size_t)g * 512 * 256 + (size_t)u.pm * 256 * 256; u.offB = (size_t)u.pn * 256 * 2048 + (size_t)g * 256;
        if (u.pn < 32) { u.ldc = 16384; u.offC = (size_t)(g * 256) * 16384 + (size_t)u.pm * 8192 + (size_t)u.pn * 256; }
        else { const int rr = u.pn - 32, bb = rr >> 4, s0 = (rr & 15) * 256; u.ldc = 8192; u.offC = (size_t)2048 * 16384 + (size_t)bb * 2048 * 8192 + (size_t)(g * 256) * 8192 + (size_t)u.pm * 4096 + s0; }
        return true;
    }
};

__device__ __forceinline__ f32x2 gelu_pk(f32x2 v) {
    const f32x2 av = __builtin_elementwise_abs(v), d = av * 0.2316418882f + 1.0f;
    f32x2 t; t.x = __builtin_amdgcn_rcpf(d.x); t.y = __builtin_amdgcn_rcpf(d.y);
    f32x2 q = t * 0.5307027145f + (-0.7265760135f); q = q * t + 0.7107068705f; q = q * t + (-0.142248368f); q = q * t + 0.127414796f; q = q * t;
    const f32x2 s = (v * v) * (-0.72134752044f);
    f32x2 e; e.x = __builtin_amdgcn_exp2f(s.x); e.y = __builtin_amdgcn_exp2f(s.y);
    const f32x2 m = v * (q * e), r = v - m;
    f32x2 o; o.x = v.x < 0.f ? m.x : r.x; o.y = v.y < 0.f ? m.y : r.y; return o;
}
template <int ACT  , int SM = 0> struct EpiBf16 {
    bf16_t* O; float scale; const float* rs;
    __device__ __forceinline__ void operator()(const f32x4 (&acc)[2][2][4][2], const Unit& u, int wr, int wc, int fr, int fq) const {
        bf16_t* base = O + u.offC + (size_t)(wr * 64 + fr) * u.ldc + wc * 32 + 8 * fq;
        f32x4 cs0[2], cs1[2];
        if (SM == 2) {
#pragma unroll
            for (int bj = 0; bj < 2; ++bj) { const float* p = rs + u.pn * BM + bj * HALF + wc * 32 + 8 * fq; cs0[bj] = *(const f32x4*)p; cs1[bj] = *(const f32x4*)(p + 4); } }
#pragma unroll
        for (int ai = 0; ai < 2; ++ai)
#pragma unroll
            for (int m = 0; m < 4; ++m) { bf16_t* rowp = base + (size_t)(ai * HALF + m * 16) * u.ldc;
                float rsc = scale; if (SM == 1) rsc = rs[u.pm * BM + ai * HALF + wr * 64 + m * 16 + fr] * scale;
#pragma unroll
                for (int bj = 0; bj < 2; ++bj) { f32x4 v0 = acc[ai][bj][m][0] * rsc, v1 = acc[ai][bj][m][1] * rsc;
                    if (SM == 2) { v0 = v0 * cs0[bj]; v1 = v1 * cs1[bj]; }
                    if (ACT == 1) { f32x2 a = gelu_pk((f32x2){v0[0], v0[1]}), b = gelu_pk((f32x2){v0[2], v0[3]}), c = gelu_pk((f32x2){v1[0], v1[1]}), d = gelu_pk((f32x2){v1[2], v1[3]});
                        v0 = (f32x4){a.x, a.y, b.x, b.y}; v1 = (f32x4){c.x, c.y, d.x, d.y}; }
                    u32x4 w; w.x = cvt_pk_bf16(v0[0], v0[1]); w.y = cvt_pk_bf16(v0[2], v0[3]); w.z = cvt_pk_bf16(v1[0], v1[1]); w.w = cvt_pk_bf16(v1[2], v1[3]);
                    *(u32x4*)(rowp + bj * HALF) = w; } }
    }
};
struct EpiSwiGLU {
    bf16_t* O; const float* rs;
    __device__ __forceinline__ void operator()(const f32x4 (&acc)[2][2][4][2], const Unit& u, int wr, int wc, int fr, int fq) const {
        bf16_t* base = O + (size_t)(u.pm * BM + wr * 64 + fr) * DFF + u.pn * 128 + wc * 32 + 8 * fq;
#pragma unroll
        for (int ai = 0; ai < 2; ++ai)
#pragma unroll
            for (int m = 0; m < 4; ++m) { bf16_t* rowp = base + (size_t)(ai * HALF + m * 16) * DFF; float r[8];
                const float rsc = rs[u.pm * BM + ai * HALF + wr * 64 + m * 16 + fr];
#pragma unroll
                for (int n = 0; n < 2; ++n)
#pragma unroll
                    for (int j = 0; j < 4; ++j) { const float g = acc[ai][0][m][n][j] * rsc, up = acc[ai][1][m][n][j] * rsc;
                        const float sg = g * __builtin_amdgcn_rcpf(1.0f + __builtin_amdgcn_exp2f(-1.4426950408889634f * g)); r[n * 4 + j] = sg * up; }
                u32x4 w; w.x = cvt_pk_bf16(r[0], r[1]); w.y = cvt_pk_bf16(r[2], r[3]); w.z = cvt_pk_bf16(r[4], r[5]); w.w = cvt_pk_bf16(r[6], r[7]);
                *(u32x4*)rowp = w; }
    }
};

template <class Epi, class Sched>
__device__ __forceinline__ void gemm_phase(const int tid, LAS unsigned char* lds, const bf16_t* Abase, const bf16_t* Bbase, const int lda, const int ldb, const int nt, const Sched& S, const Epi& E) {
    const int wid = __builtin_amdgcn_readfirstlane(tid >> 6), lane = tid & 63, wr = wid >> 2, wc = wid & 3, fr = lane & 15, fq = lane >> 4;
    unsigned voffA[2], voffB[2];
#pragma unroll
    for (int i = 0; i < 2; ++i) { int R, C; stage_rc(tid * 16 + i * 8192, R, C); const int Rb = (R & ~31) + perm32(R & 31);
        voffA[i] = (unsigned)(R * lda + C) * 2u; voffB[i] = (unsigned)(Rb * ldb + C) * 2u; }
    const size_t kstep = (size_t)(BK * 2);
    const size_t hstepA = (size_t)HALF * lda * 2, hstepB = (size_t)HALF * ldb * 2;
    const unsigned ldsw = (unsigned)wid * 1024u;
    const int aoff = lds_byte(wr * 64 + fr, fq * 8), boff = lds_byte(wc * 32 + fr, fq * 8);
#define PG8_SA(b, h) (((b) * 2 + (h)) * HTB)
#define PG8_SB(b, h) ((4 + (b) * 2 + (h)) * HTB)
#define PG8_STAGE(bufoff, gbase, voff) do { _Pragma("unroll") for (int _i = 0; _i < 2; ++_i) \
        __builtin_amdgcn_global_load_lds((const unsigned*)((const char*)(gbase) + (voff)[_i]), (LAS unsigned*)(lds + (bufoff) + ldsw + _i * 8192), 16, 0, 0); } while (0)
#define PG8_LDA(dst, b, h) do { _Pragma("unroll") for (int m = 0; m < 4; ++m) _Pragma("unroll") for (int k = 0; k < 2; ++k) dst[m][k] = *(const LAS bf16x8*)(lds + PG8_SA(b, h) + aoff + m * 2048 + k * 1024); } while (0)
#define PG8_LDB(dst, b, h) do { _Pragma("unroll") for (int n = 0; n < 2; ++n) _Pragma("unroll") for (int k = 0; k < 2; ++k) dst[n][k] = *(const LAS bf16x8*)(lds + PG8_SB(b, h) + boff + n * 2048 + k * 1024); } while (0)
#define PG8_MMA(ai, bj, At, Bt) do { __builtin_amdgcn_s_setprio(1); _Pragma("unroll") for (int m = 0; m < 4; ++m) _Pragma("unroll") for (int n = 0; n < 2; ++n) _Pragma("unroll") for (int k = 0; k < 2; ++k) \
        acc[ai][bj][m][n] = __builtin_amdgcn_mfma_f32_16x16x32_bf16(Bt[n][k], At[m][k], acc[ai][bj][m][n], 0, 0, 0); __builtin_amdgcn_s_setprio(0); } while (0)
#define PG8_WAIT_V(n) asm volatile("s_waitcnt vmcnt(" #n ")" ::: "memory")
#define PG8_WAIT_L(n) asm volatile("s_waitcnt lgkmcnt(" #n ")" ::: "memory")
#define PG8_BAR __builtin_amdgcn_s_barrier()
#define PG8_SCHED __builtin_amdgcn_sched_barrier(0)
    Unit cur, nxt; int ui = 0;
    if (!S.next(0, cur)) return;
    f32x4 acc[2][2][4][2];
#pragma unroll
    for (int a = 0; a < 2; ++a)
#pragma unroll
        for (int b = 0; b < 2; ++b)
#pragma unroll
            for (int m = 0; m < 4; ++m)
#pragma unroll
                for (int n = 0; n < 2; ++n) acc[a][b][m][n] = (f32x4){0.f, 0.f, 0.f, 0.f};
    bf16x8 At[4][2], B0[2][2], B1[2][2];
    const char* cA = (const char*)(Abase + cur.offA); const char* cB = (const char*)(Bbase + cur.offB);
    PG8_STAGE(PG8_SB(0, 0), cB, voffB); PG8_STAGE(PG8_SB(0, 1), cB + hstepB, voffB); PG8_STAGE(PG8_SA(0, 0), cA, voffA); PG8_STAGE(PG8_SA(0, 1), cA + hstepA, voffA);
    if (wr == 1) PG8_BAR;
    PG8_WAIT_V(2); PG8_BAR;
    PG8_STAGE(PG8_SB(1, 0), cB + kstep, voffB); PG8_STAGE(PG8_SA(1, 0), cA + kstep, voffA); PG8_STAGE(PG8_SB(1, 1), cB + hstepB + kstep, voffB);
    PG8_WAIT_V(6); PG8_BAR;
    for (;;) {
        const bool has_next = S.next(ui + 1, nxt);
        const char* nA = has_next ? (const char*)(Abase + nxt.offA) : cA; const char* nB = has_next ? (const char*)(Bbase + nxt.offB) : cB;
        for (int t = 0; t < nt; t += 2) {
            const bool last = (t == nt - 2);
            const char* a1 = cA + (size_t)(t + 1) * kstep;
            const char* a2 = last ? nA : cA + (size_t)(t + 2) * kstep; const char* b2 = last ? nB : cB + (size_t)(t + 2) * kstep;
            const char* a3 = a2 + kstep; const char* b3 = b2 + kstep;
            PG8_LDB(B0, 0, 0); PG8_LDB(B1, 0, 1); PG8_SCHED; PG8_LDA(At, 0, 0); PG8_STAGE(PG8_SA(1, 1), a1 + hstepA, voffA);
            PG8_WAIT_V(8); PG8_WAIT_L(0); PG8_BAR; PG8_MMA(0, 0, At, B0); PG8_MMA(0, 1, At, B1); PG8_BAR; PG8_SCHED;
            PG8_LDA(At, 0, 1); PG8_STAGE(PG8_SB(0, 0), b2, voffB); PG8_STAGE(PG8_SB(0, 1), b2 + hstepB, voffB); PG8_STAGE(PG8_SA(0, 0), a2, voffA);
            PG8_WAIT_V(8); PG8_WAIT_L(0); PG8_BAR; PG8_MMA(1, 0, At, B0); PG8_MMA(1, 1, At, B1); PG8_BAR; PG8_SCHED;
            PG8_LDB(B0, 1, 0); PG8_LDB(B1, 1, 1); PG8_SCHED; PG8_LDA(At, 1, 0); PG8_STAGE(PG8_SA(0, 1), a2 + hstepA, voffA);
            PG8_WAIT_V(8); PG8_WAIT_L(0); PG8_BAR; PG8_MMA(0, 0, At, B0); PG8_MMA(0, 1, At, B1); PG8_BAR; PG8_SCHED;
            PG8_LDA(At, 1, 1); PG8_STAGE(PG8_SB(1, 0), b3, voffB); PG8_STAGE(PG8_SB(1, 1), b3 + hstepB, voffB); PG8_STAGE(PG8_SA(1, 0), a3, voffA);
            PG8_WAIT_V(8); PG8_WAIT_L(0); PG8_BAR; PG8_MMA(1, 0, At, B0); PG8_MMA(1, 1, At, B1); PG8_BAR; PG8_SCHED;
        }
        if (wr == 0) PG8_BAR;
        { const int ln2 = lane_id_asm(); E(acc, cur, wr, wc, ln2 & 15, ln2 >> 4); }
        if (!has_next) break;
#pragma unroll
        for (int a = 0; a < 2; ++a)
#pragma unroll
            for (int b = 0; b < 2; ++b)
#pragma unroll
                for (int m = 0; m < 4; ++m)
#pragma unroll
                    for (int n = 0; n < 2; ++n) acc[a][b][m][n] = (f32x4){0.f, 0.f, 0.f, 0.f};
        cur = nxt; cA = nA; cB = nB; ++ui;
        if (wr == 1) PG8_BAR;
    }
    PG8_WAIT_V(0);
    PG8_BAR;
#undef PG8_SA
#undef PG8_SB
#undef PG8_STAGE
#undef PG8_LDA
#undef PG8_LDB
#undef PG8_MMA
#undef PG8_WAIT_V
#undef PG8_WAIT_L
#undef PG8_BAR
#undef PG8_SCHED
}
}

namespace att {
constexpr int AD = 128, NW = 8, QBLK = 32, KVBLK = 64;
constexpr float SCALE = 0.088388347648318440f;
constexpr float THR = 8.f;
constexpr size_t SHM_V = KVBLK * AD * 2, SHM_K = KVBLK * AD * 2, SHM_ATTN = 2 * SHM_V + 2 * SHM_K + NW * 64 * 4;
#define KSWZ(row, colB) ((row) * 256 + ((colB) ^ (((row) & 7) << 4)))
#define SBAR() __builtin_amdgcn_sched_barrier(0)
__device__ __forceinline__ int crow(int r, int hi) { return (r & 3) + 8 * (r >> 2) + 4 * hi; }
__device__ __forceinline__ unsigned cvtpk(float lo, float hi) { unsigned r; asm volatile("v_cvt_pk_bf16_f32 %0, %1, %2" : "=v"(r) : "v"(lo), "v"(hi)); return r; }
__device__ __forceinline__ void partialSM(f32x16& p0, f32x16& p1, float& m_reg, float& mn, float& alpha) {
  constexpr float C = SCALE * 1.4426950408889634f;
  float pmax = p0[0]; for (int r = 1; r < 16; ++r) pmax = fmaxf(pmax, p0[r]); for (int r = 0; r < 16; ++r) pmax = fmaxf(pmax, p1[r]);
  { auto rr = __builtin_amdgcn_permlane32_swap(__float_as_uint(pmax), __float_as_uint(pmax), false, false);
    pmax = fmaxf(__uint_as_float(rr[0]), __uint_as_float(rr[1])); }
  if (__builtin_expect(__all(pmax - m_reg <= THR / SCALE), 1)) { mn = m_reg; alpha = 1.f; }
  else { mn = fmaxf(m_reg, pmax); alpha = __builtin_amdgcn_exp2f((m_reg - mn) * C); m_reg = mn; }
  float mnC = -mn * C;
  for (int r = 0; r < 16; ++r) p0[r] = fmaf(p0[r], C, mnC); for (int r = 0; r < 16; ++r) p1[r] = fmaf(p1[r], C, mnC);
  for (int r = 0; r < 16; ++r) p0[r] = __builtin_amdgcn_exp2f(p0[r]);
}
__device__ __forceinline__ void finishSM(f32x16& p0, f32x16& p1, float alpha, float& l_reg, bf16x8& pa0, bf16x8& pa1, bf16x8& pa2, bf16x8& pa3) {
  for (int r = 0; r < 16; ++r) p1[r] = __builtin_amdgcn_exp2f(p1[r]);
  float ps = 0; for (int r = 0; r < 16; ++r) ps += p0[r]; for (int r = 0; r < 16; ++r) ps += p1[r];
  { auto rr = __builtin_amdgcn_permlane32_swap(__float_as_uint(ps), __float_as_uint(ps), false, false);
    ps = __uint_as_float(rr[0]) + __uint_as_float(rr[1]); }
  l_reg = l_reg * alpha + ps;
#define PK4(P, BASE, OUT) do { unsigned a0 = cvtpk(P[BASE + 0], P[BASE + 1]), a1 = cvtpk(P[BASE + 2], P[BASE + 3]);   \
    unsigned b0 = cvtpk(P[BASE + 4], P[BASE + 5]), b1 = cvtpk(P[BASE + 6], P[BASE + 7]);                              \
    auto r0 = __builtin_amdgcn_permlane32_swap(a0, b0, false, false); auto r1 = __builtin_amdgcn_permlane32_swap(a1, b1, false, false); \
    u32x4 w = {r0[0], r1[0], r0[1], r1[1]}; OUT = *reinterpret_cast<bf16x8*>(&w); } while (0)
  PK4(p0, 0, pa0); PK4(p0, 8, pa1); PK4(p1, 0, pa2); PK4(p1, 8, pa3);
#undef PK4
}
__device__ __forceinline__ void qkt(f32x16& p0, f32x16& p1, const bf16_t* Ks, const bf16x8* qr, int r32, int hi) {
  p0 = f32x16{}; p1 = f32x16{};
  for (int d0 = 0; d0 < 8; ++d0) { int cb = (d0 * 16 + hi * 8) * 2;
    bf16x8 b0 = *reinterpret_cast<const bf16x8*>((const char*)Ks + KSWZ(r32, cb));
    bf16x8 b1 = *reinterpret_cast<const bf16x8*>((const char*)Ks + KSWZ(32 + r32, cb));
    p0 = __builtin_amdgcn_mfma_f32_32x32x16_bf16(b0, qr[d0], p0, 0, 0, 0);
    p1 = __builtin_amdgcn_mfma_f32_32x32x16_bf16(b1, qr[d0], p1, 0, 0, 0); }
}
__device__ __forceinline__ int v_st(int k, int c) { const int kk = (k & ~0xC) | ((k & 4) << 1) | ((k & 8) >> 1); return ((kk >> 3) * 4 + (c >> 5)) * 512 + ((kk & 7) * 32 + (c & 31)) * 2; }
__device__ __forceinline__ int v_rd_base(int lane) { return ((lane & 3) << 3) | (((lane >> 2) & 3) << 6) | (((lane >> 4) & 1) << 5) | (((lane >> 5) & 1) << 8); }
constexpr int v_rd_off(int d0, int ks, int half) { return d0 * 512 + ks * 4096 + half * 2048; }
template <int OFF> __device__ __forceinline__ s16x4 tr_read(int vb) {
  s16x4 r; asm volatile("ds_read_b64_tr_b16 %0, %1 offset:%2" : "=&v"(r) : "v"(vb), "i"(OFF) : "memory"); return r;
}
template <int D0> __device__ __forceinline__ void pv_one(f32x16& od, int vb, bf16x8 pa0, bf16x8 pa1, bf16x8 pa2, bf16x8 pa3) {
  const s16x4 l0 = tr_read<v_rd_off(D0, 0, 0)>(vb), h0 = tr_read<v_rd_off(D0, 0, 1)>(vb), l1 = tr_read<v_rd_off(D0, 1, 0)>(vb), h1 = tr_read<v_rd_off(D0, 1, 1)>(vb);
  const s16x4 l2 = tr_read<v_rd_off(D0, 2, 0)>(vb), h2 = tr_read<v_rd_off(D0, 2, 1)>(vb), l3 = tr_read<v_rd_off(D0, 3, 0)>(vb), h3 = tr_read<v_rd_off(D0, 3, 1)>(vb);
  asm volatile("s_waitcnt lgkmcnt(0)" ::: "memory"); SBAR();
#define PK(L, H) (bf16x8){L[0], L[1], L[2], L[3], H[0], H[1], H[2], H[3]}
  od = __builtin_amdgcn_mfma_f32_32x32x16_bf16(pa0, PK(l0, h0), od, 0, 0, 0);
  od = __builtin_amdgcn_mfma_f32_32x32x16_bf16(pa1, PK(l1, h1), od, 0, 0, 0);
  od = __builtin_amdgcn_mfma_f32_32x32x16_bf16(pa2, PK(l2, h2), od, 0, 0, 0);
  od = __builtin_amdgcn_mfma_f32_32x32x16_bf16(pa3, PK(l3, h3), od, 0, 0, 0);
#undef PK
}
__device__ __forceinline__ void pv_d0(f32x16* o, int vb, bf16x8 pa0, bf16x8 pa1, bf16x8 pa2, bf16x8 pa3) {
  pv_one<0>(o[0], vb, pa0, pa1, pa2, pa3); pv_one<1>(o[1], vb, pa0, pa1, pa2, pa3); pv_one<2>(o[2], vb, pa0, pa1, pa2, pa3); pv_one<3>(o[3], vb, pa0, pa1, pa2, pa3);
}
template <int LDQ, int LDK, int LDO>
__device__ __forceinline__ void attn_dense_body(const int tid, const bf16_t* __restrict__ Qb, const bf16_t* __restrict__ Kh, const bf16_t* __restrict__ Vh, bf16_t* __restrict__ Ob, int seq, int rot, char* lds) {
  constexpr int SDEPTH = 2;
  const int wid = tid >> 6, lane = tid & 63, r32 = lane & 31, hi = lane >> 5;
  bf16_t* V_lds = (bf16_t*)lds; bf16_t* K_lds = (bf16_t*)(lds + 2 * SHM_V);
  float* ws = (float*)(lds + 2 * SHM_V + 2 * SHM_K) + wid * 64; float* li_l = ws; float* al_l = ws + 32;
  float m_reg = -1e30f, l_reg = 0; f32x16 o[4] = {}; bf16x8 qr[8];
  const bf16_t* Qw = Qb + (long)(wid * QBLK + r32) * LDQ + hi * 8;
#pragma unroll
  for (int d0 = 0; d0 < 8; ++d0) qr[d0] = *reinterpret_cast<const bf16x8*>(Qw + d0 * 16);
  const int sr = tid >> 4, sc = (tid & 15) * 8, vst0 = v_st(sr, sc), vst1 = v_st(32 + sr, sc);
  const int vb0 = (int)(uintptr_t)V_lds + v_rd_base(lane);
  struct { bf16x8 vs0, vs1, ks0, ks1; } sr_[SDEPTH];
#define LD8(p) (*reinterpret_cast<const bf16x8*>(p))
#define SLOAD(i, k0) do { sr_[i].vs0 = LD8(&Vh[(long)((k0) + sr) * LDK + sc]); sr_[i].vs1 = LD8(&Vh[(long)((k0) + 32 + sr) * LDK + sc]); \
    sr_[i].ks0 = LD8(&Kh[(long)((k0) + sr) * LDK + sc]); sr_[i].ks1 = LD8(&Kh[(long)((k0) + 32 + sr) * LDK + sc]); } while (0)
#define SWRITE(b, i) do { *(bf16x8*)((char*)V_lds + (b) * SHM_V + vst0) = sr_[i].vs0;          \
    *(bf16x8*)((char*)V_lds + (b) * SHM_V + vst1) = sr_[i].vs1; int kc = sc * 2;               \
    *(bf16x8*)((char*)K_lds + (b) * SHM_K + KSWZ(sr, kc)) = sr_[i].ks0;                       \
    *(bf16x8*)((char*)K_lds + (b) * SHM_K + KSWZ(32 + sr, kc)) = sr_[i].ks1; } while (0)
#define SWAIT() do { asm volatile("s_waitcnt vmcnt(4)" ::: "memory"); } while (0)
#define RESC(a) do { if (__any((a) < 1.f)) { if (hi == 0) al_l[r32] = (a); asm volatile("s_waitcnt lgkmcnt(0)" ::: "memory"); \
    for (int d = 0; d < 4; ++d) for (int r = 0; r < 16; ++r) o[d][r] *= al_l[crow(r, hi)]; } } while (0)
  f32x16 pA0, pA1, pB0, pB1; float mnA, mnB, alA, alB; bf16x8 pa0, pa1, pa2, pa3; const int NT = seq / KVBLK;
  const int ntm = NT - 1;
#define KT(t) ((((t) + rot) & ntm) * KVBLK)
  constexpr int SE = 0, SO = SDEPTH - 1;
  SLOAD(SE, KT(0)); asm volatile("s_waitcnt vmcnt(0)" ::: "memory"); SWRITE(0, SE); __syncthreads();
  qkt(pA0, pA1, K_lds, qr, r32, hi); partialSM(pA0, pA1, m_reg, mnA, alA);
  SLOAD(SO, KT(1)); if (2 < NT) SLOAD(SE, KT(2));
  SWAIT(); SWRITE(1, SO); __syncthreads();
  for (int j = 1; j + 1 < NT; j += 2) {
    SBAR(); qkt(pB0, pB1, (bf16_t*)((char*)K_lds + SHM_K), qr, r32, hi);
    finishSM(pA0, pA1, alA, l_reg, pa0, pa1, pa2, pa3); SBAR();
    SLOAD(SO, KT(j + SDEPTH)); SBAR();
    pv_d0(o, vb0, pa0, pa1, pa2, pa3); partialSM(pB0, pB1, m_reg, mnB, alB);
    __syncthreads(); SWAIT(); SWRITE(0, SE);
    RESC(alB); __syncthreads();
    SBAR(); qkt(pA0, pA1, K_lds, qr, r32, hi);
    finishSM(pB0, pB1, alB, l_reg, pa0, pa1, pa2, pa3); SBAR();
    if (j + 3 < NT) SLOAD(SE, KT(j + 1 + SDEPTH)); SBAR();
    pv_d0(o, vb0 + (int)SHM_V, pa0, pa1, pa2, pa3); partialSM(pA0, pA1, m_reg, mnA, alA);
    __syncthreads(); SWAIT(); SWRITE(1, SO);
    RESC(alA); __syncthreads();
  }
  SBAR(); qkt(pB0, pB1, (bf16_t*)((char*)K_lds + SHM_K), qr, r32, hi);
  finishSM(pA0, pA1, alA, l_reg, pa0, pa1, pa2, pa3); SBAR();
  pv_d0(o, vb0, pa0, pa1, pa2, pa3); partialSM(pB0, pB1, m_reg, mnB, alB);
  __syncthreads(); RESC(alB);
  finishSM(pB0, pB1, alB, l_reg, pa0, pa1, pa2, pa3); SBAR();
  pv_d0(o, vb0 + (int)SHM_V, pa0, pa1, pa2, pa3);
  if (hi == 0) li_l[r32] = l_reg; asm volatile("s_waitcnt lgkmcnt(0)" ::: "memory");
  float rli[16];
#pragma unroll
  for (int r = 0; r < 16; ++r) rli[r] = __builtin_amdgcn_rcpf(li_l[crow(r, hi)]);
  bf16_t* Ow = Ob + (long)(wid * QBLK) * LDO;
#pragma unroll
  for (int r = 0; r < 16; ++r) { int orow = crow(r, hi);
    for (int d0 = 0; d0 < 4; ++d0) Ow[(long)orow * LDO + d0 * 32 + r32] = (bf16_t)f2bf(o[d0][r] * rli[r]); }
#undef KT
#undef LD8
#undef SLOAD
#undef SWRITE
#undef SWAIT
#undef RESC
}
}

namespace att2 {
using namespace att;
constexpr int KST = 16384, VST = 32768;
constexpr int V_OFF = 2 * KST;
constexpr int SCR_OFF = 133120;
template <int OFF> __device__ __forceinline__ bf16x8 lds_read128(int addr) { bf16x8 r; asm volatile("ds_read_b128 %0, %1 offset:%2" : "=&v"(r) : "v"(addr), "i"(OFF) : "memory"); return r; }
#define A2_WAIT_L(n) asm volatile("s_waitcnt lgkmcnt(" #n ")" ::: "memory")
__device__ __forceinline__ void qkt_l(f32x16& p0, f32x16& p1, const int kb, const int hx, const bf16x8* qr) {
  p0 = f32x16{}; p1 = f32x16{};
  bf16x8 c0 = lds_read128<0>(kb + hx), c1 = lds_read128<8192>(kb + hx);
#pragma unroll
  for (int d0 = 0; d0 < 8; ++d0) { bf16x8 n0 = c0, n1 = c1;
    if (d0 < 7) { const int a = kb + (((d0 + 1) << 5) ^ hx); n0 = lds_read128<0>(a); n1 = lds_read128<8192>(a); A2_WAIT_L(2); } else { A2_WAIT_L(0); }
    SBAR();
    p0 = __builtin_amdgcn_mfma_f32_32x32x16_bf16(c0, qr[d0], p0, 0, 0, 0);
    p1 = __builtin_amdgcn_mfma_f32_32x32x16_bf16(c1, qr[d0], p1, 0, 0, 0);
    c0 = n0; c1 = n1; }
}
template <int BLK> __device__ __forceinline__ void pv_read8(s16x4 (&f)[8], int vb) {
  constexpr int B0 = (BLK >> 2) * 16384 + (BLK & 3) * 512;
  f[0] = tr_read<B0>(vb); f[1] = tr_read<B0 + 2048>(vb); f[2] = tr_read<B0 + 4096>(vb); f[3] = tr_read<B0 + 4096 + 2048>(vb);
  f[4] = tr_read<B0 + 8192>(vb); f[5] = tr_read<B0 + 8192 + 2048>(vb); f[6] = tr_read<B0 + 12288>(vb); f[7] = tr_read<B0 + 12288 + 2048>(vb);
}
__device__ __forceinline__ void pv_mma(f32x16& od, const s16x4 (&f)[8], bf16x8 pa0, bf16x8 pa1, bf16x8 pa2, bf16x8 pa3) {
#define PK(L, H) (bf16x8){L[0], L[1], L[2], L[3], H[0], H[1], H[2], H[3]}
  od = __builtin_amdgcn_mfma_f32_32x32x16_bf16(pa0, PK(f[0], f[1]), od, 0, 0, 0);
  od = __builtin_amdgcn_mfma_f32_32x32x16_bf16(pa1, PK(f[2], f[3]), od, 0, 0, 0);
  od = __builtin_amdgcn_mfma_f32_32x32x16_bf16(pa2, PK(f[4], f[5]), od, 0, 0, 0);
  od = __builtin_amdgcn_mfma_f32_32x32x16_bf16(pa3, PK(f[6], f[7]), od, 0, 0, 0);
#undef PK
}
__device__ __forceinline__ void pv_pipe(f32x16* o, int vb, bf16x8 pa0, bf16x8 pa1, bf16x8 pa2, bf16x8 pa3) {
  s16x4 fa[8], fb[8];
  pv_read8<0>(fa, vb);
  pv_read8<1>(fb, vb); A2_WAIT_L(8); SBAR(); pv_mma(o[0], fa, pa0, pa1, pa2, pa3); SBAR();
  pv_read8<2>(fa, vb); A2_WAIT_L(8); SBAR(); pv_mma(o[1], fb, pa0, pa1, pa2, pa3); SBAR();
  pv_read8<3>(fb, vb); A2_WAIT_L(8); SBAR(); pv_mma(o[2], fa, pa0, pa1, pa2, pa3); SBAR();
  pv_read8<4>(fa, vb); A2_WAIT_L(8); SBAR(); pv_mma(o[3], fb, pa0, pa1, pa2, pa3); SBAR();
  pv_read8<5>(fb, vb); A2_WAIT_L(8); SBAR(); pv_mma(o[4], fa, pa0, pa1, pa2, pa3); SBAR();
  pv_read8<6>(fa, vb); A2_WAIT_L(8); SBAR(); pv_mma(o[5], fb, pa0, pa1, pa2, pa3); SBAR();
  pv_read8<7>(fb, vb); A2_WAIT_L(8); SBAR(); pv_mma(o[6], fa, pa0, pa1, pa2, pa3); SBAR();
  A2_WAIT_L(0); SBAR(); pv_mma(o[7], fb, pa0, pa1, pa2, pa3);
}
template <int LDQ, int LDK, int LDO>
__device__ __forceinline__ void attn256_body(const int tid, const bf16_t* __restrict__ Qb, const bf16_t* __restrict__ Kh, const bf16_t* __restrict__ Vh, bf16_t* __restrict__ Ob, const int seq, LAS unsigned char* lds) {
  const int wid = __builtin_amdgcn_readfirstlane(tid >> 6), lane = tid & 63, r32 = lane & 31, hi = lane >> 5;
  const bool grpB = wid >= 4;
  LAS float* ws = (LAS float*)(lds + SCR_OFF) + wid * 64; LAS float* li_l = ws; LAS float* al_l = ws + 32;
  float m_reg = -1e30f, l_reg = 0; f32x16 o[8] = {}; bf16x8 qr[8];
  const bf16_t* Qw = Qb + (long)(wid * QBLK + r32) * LDQ + hi * 8;
#pragma unroll
  for (int d0 = 0; d0 < 8; ++d0) qr[d0] = *reinterpret_cast<const bf16x8*>(Qw + d0 * 16);
  unsigned koff[2], voff[2][2];
#pragma unroll
  for (int i = 0; i < 2; ++i) { const int ob = i * 8192 + wid * 1024 + lane * 16;
    { const int row = ob >> 8, cb = ob & 255; koff[i] = (unsigned)(row * LDK * 2 + (cb ^ ((row & 7) << 4))); }
    { const int sub = ob >> 9, kkhi = sub >> 2, cblk = sub & 3, w_ = (ob & 511) >> 1, kk = kkhi * 8 + (w_ >> 5), c = cblk * 32 + (w_ & 31);
      const int k = (kk & ~0xC) | ((kk & 4) << 1) | ((kk & 8) >> 1);
      voff[0][i] = (unsigned)(k * LDK * 2 + c * 2); voff[1][i] = voff[0][i] + 256u; } }
  const unsigned ldsw = (unsigned)wid * 1024u;
  const int vrb = (int)(uintptr_t)lds + V_OFF + v_rd_base(lane);
  const int krb = (int)(uintptr_t)lds + r32 * 256, hx = (hi * 16) ^ ((r32 & 7) << 4);
#define A2_ISSUE(t, ks, vs) do { const char* kb_ = (const char*)Kh + (size_t)(t) * (KVBLK * LDK * 2); const char* vb_ = (const char*)Vh + (size_t)(t) * (KVBLK * LDK * 2); \
    _Pragma("unroll") for (int i_ = 0; i_ < 2; ++i_) { \
      __builtin_amdgcn_global_load_lds((const unsigned*)(kb_ + koff[i_]), (LAS unsigned*)(lds + (ks) * KST + i_ * 8192 + ldsw), 16, 0, 0); \
      __builtin_amdgcn_global_load_lds((const unsigned*)(vb_ + voff[0][i_]), (LAS unsigned*)(lds + V_OFF + (vs) * VST + i_ * 8192 + ldsw), 16, 0, 0); \
      __builtin_amdgcn_global_load_lds((const unsigned*)(vb_ + voff[1][i_]), (LAS unsigned*)(lds + V_OFF + (vs) * VST + 16384 + i_ * 8192 + ldsw), 16, 0, 0); } } while (0)
#define A2_PV(vs) pv_pipe(o, vrb + (vs) * VST, pa0, pa1, pa2, pa3)
  const int NT = seq / KVBLK;
  bf16x8 pa0, pa1, pa2, pa3;
  A2_ISSUE(0, 0, 0);
  int vs = 0, vsp = 2;
  for (int t = 0; t < NT; ++t) {
    asm volatile("s_waitcnt vmcnt(0)" ::: "memory"); __builtin_amdgcn_s_barrier(); asm volatile("" ::: "memory");
    const int vsn = (vs == 2) ? 0 : vs + 1;
    if (t + 1 < NT) A2_ISSUE(t + 1, (t + 1) & 1, vsn);
    if (grpB && t > 0) A2_PV(vsp);
    f32x16 p0, p1; float mn, alpha;
    qkt_l(p0, p1, krb + (t & 1) * KST, hx, qr);
    partialSM(p0, p1, m_reg, mn, alpha);
    if (__any(alpha < 1.f)) { if (hi == 0) al_l[r32] = alpha; asm volatile("s_waitcnt lgkmcnt(0)" ::: "memory");
#pragma unroll
      for (int d = 0; d < 8; ++d)
#pragma unroll
        for (int r = 0; r < 16; ++r) o[d][r] *= al_l[crow(r, hi)]; }
    finishSM(p0, p1, alpha, l_reg, pa0, pa1, pa2, pa3); SBAR();
    if (!grpB) A2_PV(vs);
    vsp = vs; vs = vsn;
  }
  if (grpB) A2_PV(vsp);
#undef A2_ISSUE
#undef A2_PV
#undef A2_WAIT_L
  if (hi == 0) li_l[r32] = l_reg; asm volatile("s_waitcnt lgkmcnt(0)" ::: "memory");
  float rli[16];
#pragma unroll
  for (int r = 0; r < 16; ++r) rli[r] = __builtin_amdgcn_rcpf(li_l[crow(r, hi)]);
  __builtin_amdgcn_s_barrier(); asm volatile("" ::: "memory");
  bf16_t* Ow = Ob + (long)(wid * QBLK) * LDO;
#pragma unroll
  for (int r = 0; r < 16; ++r) { const int orow = crow(r, hi);
#pragma unroll
    for (int d0 = 0; d0 < 8; ++d0) Ow[(long)orow * LDO + d0 * 32 + r32] = (bf16_t)f2bf(o[d0][r] * rli[r]); }
}
}

#define XB_TMO      128
#define XB_XCNT(j)  (256  + 64 * (j))
#define XB_XSUB(j)  (1280 + 64 * (j))
#define XB_XGEN(j)  (2304 + 64 * (j))
#define XB_TOP      3328
#define XB_TOPGEN   3392
#define XCD_BAR_WORDS 3456
#define XB_SPIN_CAP (1u << 18)
__device__ __forceinline__ unsigned xb_ld(unsigned* p)              { return __hip_atomic_load(p, __ATOMIC_RELAXED, __HIP_MEMORY_SCOPE_AGENT); }
__device__ __forceinline__ unsigned xb_add(unsigned* p, unsigned v) { return __hip_atomic_fetch_add(p, v, __ATOMIC_RELAXED, __HIP_MEMORY_SCOPE_AGENT); }
__device__ __forceinline__ unsigned xb_xcc_id() { return (unsigned)__builtin_amdgcn_s_getreg((3 << 11) | 20) & 0xFu; }
#define XB_SPIN(cond, bar) do { unsigned _sp = 0; while (cond) { __builtin_amdgcn_s_sleep(1); \
    if ((++_sp & 255u) == 0u) { if (xb_ld(&(bar)[XB_TMO])) break; if (_sp > XB_SPIN_CAP) { atomicAdd(&(bar)[XB_TMO], 1u); break; } } } } while (0)
struct XcdBarrier { unsigned* bar; unsigned x; volatile LAS unsigned* st; };
__device__ __forceinline__ XcdBarrier xcd_barrier_post(unsigned* bar, volatile LAS unsigned* st) {
    XcdBarrier b; b.bar = bar; b.x = xb_xcc_id(); b.st = st;
    if (threadIdx.x == 0) (void)xb_add(&bar[XB_XCNT(b.x)], 1u);
    return b;
}
__device__ __forceinline__ void xcd_barrier_complete(unsigned* bar, unsigned x, unsigned& nloc, unsigned& nx) {
    const unsigned G = gridDim.x * gridDim.y * gridDim.z;
    unsigned sum, cnt, mine, sp = 0u;
    for (;;) {
        sum = 0u; cnt = 0u; mine = 0u;
#pragma unroll
        for (unsigned j = 0; j < 16; ++j) { const unsigned c = xb_ld(&bar[XB_XCNT(j)]); sum += c; cnt += (c > 0u) ? 1u : 0u; mine = (j == x) ? c : mine; }
        if (sum == G) break;
        __builtin_amdgcn_s_sleep(1);
        if ((++sp & 255u) == 0u) { if (xb_ld(&bar[XB_TMO])) break; if (sp > XB_SPIN_CAP) { atomicAdd(&bar[XB_TMO], 1u); break; } }
    }
    nloc = mine > 0u ? mine : 1u; nx = cnt > 0u ? cnt : 1u;
}
__device__ __forceinline__ void xcd_barrier(const XcdBarrier& b) {
    asm volatile("s_waitcnt vmcnt(0)" ::: "memory");
    __syncthreads();
    if (threadIdx.x == 0) {
        unsigned* bar = b.bar;
        __builtin_amdgcn_s_waitcnt(0);
        unsigned nloc = b.st[0], nx = b.st[1];
        if (nloc == 0u) { xcd_barrier_complete(bar, b.x, nloc, nx); b.st[0] = nloc; b.st[1] = nx; }
        const unsigned old = xb_add(&bar[XB_XSUB(b.x)], 1u);
        const unsigned gen = old / nloc;
        if (old + 1u == (gen + 1u) * nloc) {
            __builtin_amdgcn_fence(__ATOMIC_RELEASE, "agent");
            asm volatile("s_waitcnt vmcnt(0)" ::: "memory");
            const unsigned og = xb_add(&bar[XB_TOP], 1u);
            const unsigned tg = og / nx;
            if (og + 1u == (tg + 1u) * nx) xb_add(&bar[XB_TOPGEN], 1u);
            else XB_SPIN(xb_ld(&bar[XB_TOPGEN]) == tg, bar);
            __builtin_amdgcn_fence(__ATOMIC_ACQUIRE, "agent");
            xb_add(&bar[XB_XGEN(b.x)], 1u);
            asm volatile("s_waitcnt vmcnt(0)" ::: "memory");
        } else {
            XB_SPIN(xb_ld(&bar[XB_XGEN(b.x)]) == gen, bar);
            __builtin_amdgcn_fence(__ATOMIC_ACQUIRE, "agent");
            asm volatile("s_waitcnt vmcnt(0)" ::: "memory");
        }
    }
    __syncthreads();
}

__device__ __forceinline__ void transpose_item(const float* W, int K, int N, bf16_t* WT, int mode, const float* gk, LAS float* scr, int item, int lane) {
    const int nblk = N / 32, kb = item / nblk, nb = item % nblk, k0 = 64 * kb, n0 = 32 * nb;
    const int r0 = mode == 0 ? n0 : ((n0 >> 7) * 256 + (n0 & 127) + (mode == 2 ? 128 : 0));
#pragma unroll 8
    for (int i = 0; i < 32; ++i) { const int kk = 2 * i + (lane >> 5); const float gv = gk ? gk[k0 + kk] : 1.0f; scr[kk * 33 + (lane & 31)] = W[(size_t)(k0 + kk) * N + n0 + (lane & 31)] * gv; }
    LDS_WAIT(); asm volatile("" ::: "memory");
    const int c = lane & 7;
#pragma unroll
    for (int j = 0; j < 4; ++j) { const int n = (lane >> 3) + 8 * j; const LAS float* s = scr + (8 * c) * 33 + n;
        u32x4 o; o.x = cvt_pk_bf16(s[0 * 33], s[1 * 33]); o.y = cvt_pk_bf16(s[2 * 33], s[3 * 33]); o.z = cvt_pk_bf16(s[4 * 33], s[5 * 33]); o.w = cvt_pk_bf16(s[6 * 33], s[7 * 33]);
        *(GAS u32x4*)(WT + (size_t)(r0 + n) * K + k0 + 8 * c) = o; }
    LDS_WAIT(); asm volatile("" ::: "memory");
}
__device__ __forceinline__ void transpose_matrix(const float* W, int K, int N, bf16_t* WT, int mode, const float* gk, LAS float* scr, int gw, int NGW, int lane, int& base) {
    const int n = (K / 64) * (N / 32);
    int first = (gw - base % NGW + NGW) % NGW;
    for (int it = first; it < n; it += NGW) transpose_item(W, K, N, WT, mode, gk, scr, it, lane);
    base += n;
}
struct TrItem { const float* W; bf16_t* WT; const float* gk; int K, N, r0, k0, n0; };
__device__ __forceinline__ void ffn_item(int it, const float* Wg, const float* Wu, const float* Wd, const float* gk, bf16_t* W1, bf16_t* WD, TrItem& t) {
    constexpr int NI = (D / 64) * (DFF / 32);
    int mode, item;
    if (it < NI) { t.W = Wg; t.WT = W1; t.gk = gk; t.K = D; t.N = DFF; mode = 1; item = it; }
    else if (it < 2 * NI) { t.W = Wu; t.WT = W1; t.gk = gk; t.K = D; t.N = DFF; mode = 2; item = it - NI; }
    else { t.W = Wd; t.WT = WD; t.gk = nullptr; t.K = DFF; t.N = D; mode = 0; item = it - 2 * NI; }
    const int nblk = t.N / 32, kb = item / nblk, nb = item % nblk; t.k0 = 64 * kb; t.n0 = 32 * nb;
    t.r0 = mode == 0 ? t.n0 : ((t.n0 >> 7) * 256 + (t.n0 & 127) + (mode == 2 ? 128 : 0));
}
__device__ __forceinline__ void tr_load(const TrItem& t, float (&r)[32], int lane) {
    const float* p = t.W + (size_t)(t.k0 + (lane >> 5)) * t.N + t.n0 + (lane & 31);
#pragma unroll
    for (int i = 0; i < 32; ++i) r[i] = *(const GAS float*)(p + (size_t)(2 * i) * t.N);
}
__device__ __forceinline__ void tr_store(const TrItem& t, const float (&r)[32], LAS float* scr, int lane) {
#pragma unroll
    for (int i = 0; i < 32; ++i) scr[(2 * i + (lane >> 5)) * 33 + (lane & 31)] = r[i];
    LDS_WAIT(); asm volatile("" ::: "memory");
    const int c = lane & 7;
    f32x4 g0 = (f32x4){1.f, 1.f, 1.f, 1.f}, g1 = g0;
    if (t.gk) { g0 = *(const f32x4*)(t.gk + t.k0 + 8 * c); g1 = *(const f32x4*)(t.gk + t.k0 + 8 * c + 4); }
#pragma unroll
    for (int j = 0; j < 4; ++j) { const int n = (lane >> 3) + 8 * j; const LAS float* s = scr + (8 * c) * 33 + n;
        u32x4 o; o.x = cvt_pk_bf16(s[0 * 33] * g0.x, s[1 * 33] * g0.y); o.y = cvt_pk_bf16(s[2 * 33] * g0.z, s[3 * 33] * g0.w); o.z = cvt_pk_bf16(s[4 * 33] * g1.x, s[5 * 33] * g1.y); o.w = cvt_pk_bf16(s[6 * 33] * g1.z, s[7 * 33] * g1.w);
        *(GAS u32x4*)(t.WT + (size_t)(t.r0 + n) * t.K + t.k0 + 8 * c) = o; }
    LDS_WAIT(); asm volatile("" ::: "memory");
}
__device__ __forceinline__ void convert_ffn_weights(const float* Wg, const float* Wu, const float* Wd, const float* gk, bf16_t* W1, bf16_t* WD, LAS float* scr, int gw, int NGW, int lane) {
    constexpr int TOTAL = 2 * (D / 64) * (DFF / 32) + (DFF / 64) * (D / 32);
    int it = gw; if (it >= TOTAL) return;
    TrItem a, b; float ra[32], rb[32];
    ffn_item(it, Wg, Wu, Wd, gk, W1, WD, a); tr_load(a, ra, lane);
    for (;;) {
        int nx = it + NGW; bool hn = nx < TOTAL;
        if (hn) { ffn_item(nx, Wg, Wu, Wd, gk, W1, WD, b); tr_load(b, rb, lane); }
        tr_store(a, ra, scr, lane);
        if (!hn) break;
        it = nx + NGW; hn = it < TOTAL;
        if (hn) { ffn_item(it, Wg, Wu, Wd, gk, W1, WD, a); tr_load(a, ra, lane); }
        tr_store(b, rb, scr, lane);
        if (!hn) break;
    }
}

template <bool FIRST, bool LAST>
__device__ __forceinline__ void rowpass(const float* xp, const float* xs, bf16_t* xb, float* xout, const bf16_t* f, float* rstd, const float* gpost, float scale, int gw, int NGW, int lane) {
    f32x4 gp[4][2];
#pragma unroll
    for (int j = 0; j < 4; ++j) { gp[j][0] = FIRST ? (f32x4){0.f, 0.f, 0.f, 0.f} : *(const f32x4*)(gpost + 512 * j + 8 * lane); gp[j][1] = FIRST ? (f32x4){0.f, 0.f, 0.f, 0.f} : *(const f32x4*)(gpost + 512 * j + 8 * lane + 4); }
    for (int row = gw; row < NTOK; row += NGW) {
        f32x4 x[4][2];
        if (FIRST) { const float* xrow = row < NPROMPT ? xp + (size_t)row * D : xs + (size_t)(row - NPROMPT) * D;
#pragma unroll
            for (int j = 0; j < 4; ++j) { x[j][0] = *(const GAS f32x4*)(xrow + 512 * j + 8 * lane); x[j][1] = *(const GAS f32x4*)(xrow + 512 * j + 8 * lane + 4); }
        } else {
            u32x4 xv[4], fv[4];
#pragma unroll
            for (int j = 0; j < 4; ++j) { xv[j] = *(const GAS u32x4*)(xb + (size_t)row * D + 512 * j + 8 * lane); fv[j] = *(const GAS u32x4*)(f + (size_t)row * D + 512 * j + 8 * lane); }
            float ss = 0.f; f32x4 ff[4][2];
#pragma unroll
            for (int j = 0; j < 4; ++j) { ff[j][0] = (f32x4){bf_lo(fv[j].x), bf_hi(fv[j].x), bf_lo(fv[j].y), bf_hi(fv[j].y)}; ff[j][1] = (f32x4){bf_lo(fv[j].z), bf_hi(fv[j].z), bf_lo(fv[j].w), bf_hi(fv[j].w)};
                x[j][0] = (f32x4){bf_lo(xv[j].x), bf_hi(xv[j].x), bf_lo(xv[j].y), bf_hi(xv[j].y)}; x[j][1] = (f32x4){bf_lo(xv[j].z), bf_hi(xv[j].z), bf_lo(xv[j].w), bf_hi(xv[j].w)};
#pragma unroll
                for (int h = 0; h < 2; ++h) ss += (ff[j][h].x * ff[j][h].x + ff[j][h].y * ff[j][h].y) + (ff[j][h].z * ff[j][h].z + ff[j][h].w * ff[j][h].w); }
            const float r = rsqrtf(wave_sum(ss, lane) * (1.0f / D) + 1e-6f) * scale;
#pragma unroll
            for (int j = 0; j < 4; ++j) { x[j][0] = x[j][0] + ff[j][0] * r * gp[j][0]; x[j][1] = x[j][1] + ff[j][1] * r * gp[j][1]; }
        }
        if (LAST) {
#pragma unroll
            for (int j = 0; j < 4; ++j) { *(GAS f32x4*)(xout + (size_t)row * D + 512 * j + 8 * lane) = x[j][0]; *(GAS f32x4*)(xout + (size_t)row * D + 512 * j + 8 * lane + 4) = x[j][1]; }
        } else {
            float s2 = 0.f;
#pragma unroll
            for (int j = 0; j < 4; ++j) { u32x4 w; w.x = cvt_pk_bf16(x[j][0].x, x[j][0].y); w.y = cvt_pk_bf16(x[j][0].z, x[j][0].w); w.z = cvt_pk_bf16(x[j][1].x, x[j][1].y); w.w = cvt_pk_bf16(x[j][1].z, x[j][1].w);
                *(GAS u32x4*)(xb + (size_t)row * D + 512 * j + 8 * lane) = w;
#pragma unroll
                for (int h = 0; h < 2; ++h) s2 += (x[j][h].x * x[j][h].x + x[j][h].y * x[j][h].y) + (x[j][h].z * x[j][h].z + x[j][h].w * x[j][h].w); }
            const float r2 = rsqrtf(wave_sum(s2, lane) * (1.0f / D) + 1e-6f);
            if (lane == 0) rstd[row] = r2;
        }
    }
}

__device__ __forceinline__ void sincos_d(double x, double& s, double& c) {
    const double n = rint(x * 0.63661977236758134308);
    double r = x - n * 1.57079632679489655800e+00; r = r - n * 6.12323399573676603587e-17;
    const long long q = (long long)n;
    const double r2 = r * r;
    double sp = -7.6471637318198164759e-13;
    sp = sp * r2 + 1.6059043836821614599e-10; sp = sp * r2 - 2.5052108385441718775e-08; sp = sp * r2 + 2.7557319223985890653e-06; sp = sp * r2 - 1.9841269841269841270e-04;
    sp = sp * r2 + 8.3333333333333333333e-03; sp = sp * r2 - 1.6666666666666666667e-01; const double sr = r + r * r2 * sp;
    double cp = 4.7794773323873852974e-14;
    cp = cp * r2 - 1.1470745597729724714e-11; cp = cp * r2 + 2.0876756987868098979e-09; cp = cp * r2 - 2.7557319223985890653e-07; cp = cp * r2 + 2.4801587301587301587e-05;
    cp = cp * r2 - 1.3888888888888888889e-03; cp = cp * r2 + 4.1666666666666666667e-02; cp = cp * r2 - 0.5; const double cr = 1.0 + r2 * cp;
    const int qq = (int)(q & 3);
    s = (qq == 0) ? sr : (qq == 1) ? cr : (qq == 2) ? -sr : -cr;
    c = (qq == 0) ? cr : (qq == 1) ? -sr : (qq == 2) ? -cr : sr;
}

struct Args { const float* in[27]; float* out; unsigned char* ws; int ph_lo, ph_hi; };
static_assert(sizeof(Args) == 29 * 8 + 8, "Args has no padding");

__host__ __device__ constexpr int mixer_phases(int kind) { return kind == 1 ? 4 : (kind == 0 ? 3 : 2); }
__host__ __device__ constexpr int total_phases() {
    int n = 2;
    for (int l = 0; l < NLAYER; ++l) n += 3 + mixer_phases(l % 3) + 2 + 4 + 3;
    return n;
}

typedef const __attribute__((address_space(4))) Args* KArgsP;
__global__ void __launch_bounds__(NTHREADS, 2) trunk_fwd(Args args) {
    extern __shared__ __attribute__((aligned(16))) unsigned char lds_raw[];
    LAS unsigned char* const lds = (LAS unsigned char*)lds_raw;
    volatile LAS unsigned* const MISC = (volatile LAS unsigned*)(lds + MISC_OFF);
    const int G = gridDim.x, bx = blockIdx.x;
    const int vcu = (G % 8 == 0) ? (bx % 8) * (G / 8) + bx / 8 : bx;
    const int NGW = G * NWAVES;
    const int wave_s = __builtin_amdgcn_readfirstlane((int)threadIdx.x >> 6);
    for (int u = threadIdx.x; u < (LDS_BYTES - RING_BYTES) / 4; u += NTHREADS) ((LAS unsigned*)(lds + RING_BYTES))[u] = 0u;
    __syncthreads();
    const int lo = args.ph_lo, hi = args.ph_hi;
    if (hi - lo > 1) (void)xcd_barrier_post((unsigned*)(args.ws + WS_CTL) + CW_BAR, MISC + 8);

    int ph = 0;
    unsigned long long pr_acc = 0, pr_prev = PROBE_T ? __builtin_amdgcn_s_memrealtime() : 0ull;
#define PH_BEGIN(kind) if (ph >= lo && ph < hi) { \
        KArgsP ap = (KArgsP)__builtin_amdgcn_kernarg_segment_ptr(); asm volatile("" : "+s"(ap)); \
        const int wave = wave_s; const int tid = wave_s * 64 + lane_id_asm(); \
        const int lane = tid & 63; const int gw = vcu * NWAVES + wave; \
        unsigned char* const ws = ap->ws; (void)lane; (void)gw; (void)ws;
#define PH_END(kind) } if (ph >= lo && ph + 1 < hi) { KArgsP ap2 = (KArgsP)__builtin_amdgcn_kernarg_segment_ptr(); asm volatile("" : "+s"(ap2)); \
        XcdBarrier b_; b_.bar = (unsigned*)(ap2->ws + WS_CTL) + CW_BAR; b_.x = xb_xcc_id(); b_.st = MISC + 8; xcd_barrier(b_); } ++ph; \
        if (PROBE_T) { const unsigned long long tn_ = __builtin_amdgcn_s_memrealtime(); if ((PROBE_T >> (kind)) & 1) pr_acc += tn_ - pr_prev; pr_prev = tn_; }
#define WSP(T, OFF) ((T*)(ws + (OFF)))

    PH_BEGIN(0)
        LAS float* scr = (LAS float*)(lds + wave * 16384);
        const float* a_w_in = ap->in[10]; const float* a_w_out = ap->in[15]; const float* ln_pre = ap->in[4];
        int base = 0;
        for (int s = 0; s < 2; ++s) transpose_matrix(a_w_in + (size_t)s * D * 4096, D, 4096, WSP(bf16_t, WS_AWIN) + (size_t)s * 4096 * D, 0, ln_pre + (size_t)(3 * s * 4 + 1) * D, scr, gw, NGW, lane, base);
        for (int s = 0; s < 2; ++s) transpose_matrix(a_w_out + (size_t)s * D * D, D, D, WSP(bf16_t, WS_AWOUT) + (size_t)s * D * D, 0, nullptr, scr, gw, NGW, lane, base);
        transpose_matrix(ap->in[16], D, 6144, WSP(bf16_t, WS_BWQKV), 0, ln_pre + (size_t)(1 * 4 + 1) * D, scr, gw, NGW, lane, base);
        transpose_matrix(ap->in[22], D, D, WSP(bf16_t, WS_BWOUT), 0, nullptr, scr, gw, NGW, lane, base);
        transpose_matrix(ap->in[23], D, D, WSP(bf16_t, WS_CWOUT), 0, nullptr, scr, gw, NGW, lane, base);
        for (int l = 0; l < NLAYER; ++l) {
            transpose_matrix(ap->in[24] + (size_t)l * D * 512, D, 512, WSP(bf16_t, WS_XWQ) + (size_t)l * 512 * D, 0, ln_pre + (size_t)(l * 4 + 2) * D, scr, gw, NGW, lane, base);
            transpose_matrix(ap->in[25] + (size_t)l * D * 1024, D, 1024, WSP(bf16_t, WS_XWKV) + (size_t)l * 1024 * D, 0, nullptr, scr, gw, NGW, lane, base);
            transpose_matrix(ap->in[26] + (size_t)l * 512 * D, 512, D, WSP(bf16_t, WS_XWOUT) + (size_t)l * D * 512, 0, nullptr, scr, gw, NGW, lane, base);
        }
        convert_ffn_weights(ap->in[7], ap->in[8], ap->in[9], ln_pre, WSP(bf16_t, WS_W1), WSP(bf16_t, WS_WD), scr, gw, NGW, lane);
        rowpass<true, false>(ap->in[0], ap->in[1], WSP(bf16_t, WS_H), nullptr, nullptr, WSP(float, WS_RSTD), nullptr, 1.f, gw, NGW, lane);
        { const float* mem_prompt = ap->in[2]; const float* mem_sample = ap->in[3]; const float* ln_mem = ap->in[6]; bf16_t* MEMN = WSP(bf16_t, WS_MEMN);
        for (int idx = gw; idx < NLAYER * NMEMTOK; idx += NGW) { const int l = idx / NMEMTOK, r = idx % NMEMTOK;
            const float* src = r < 256 ? mem_prompt + (size_t)r * D : mem_sample + (size_t)(r - 256) * D;
            const GAS f32x4* xr = (const GAS f32x4*)src + lane; f32x4 x[8]; float s2 = 0.f;
#pragma unroll
            for (int j = 0; j < 8; ++j) { x[j] = xr[64 * j]; s2 += (x[j].x * x[j].x + x[j].y * x[j].y) + (x[j].z * x[j].z + x[j].w * x[j].w); }
            const float r2 = rsqrtf(wave_sum(s2, lane) * (1.0f / D) + 1e-6f);
            GAS u32x2* ho = (GAS u32x2*)(MEMN + ((size_t)l * NMEMTOK + r) * D) + lane;
#pragma unroll
            for (int j = 0; j < 8; ++j) { const f32x4 g = *(const f32x4*)(ln_mem + l * D + 256 * j + 4 * lane); const f32x4 v = x[j] * r2 * g; u32x2 w; w.x = cvt_pk_bf16(v.x, v.y); w.y = cvt_pk_bf16(v.z, v.w); ho[64 * j] = w; } } }
        { float* ropeC = WSP(float, WS_ROPE_COS); float* ropeS = WSP(float, WS_ROPE_SIN); bf16_t* csT = WSP(bf16_t, WS_CS); bf16_t* wspT = WSP(bf16_t, WS_WSP); const float* a_w_s = ap->in[13];
        const float* gF = ln_pre + (size_t)(2 * 4 + 1) * D;
        const int gt = vcu * NTHREADS + tid, NGT = G * NTHREADS;
        for (int idx = gt; idx < 8192 * 16; idx += NGT) { const int pos = idx >> 4, j = idx & 15;
            const float invf = (float)exp(-13.122363377404328 * (double)j * 0.0625);
            const float ang = (float)pos * invf; double s, c; sincos_d((double)ang, s, c); ropeC[idx] = (float)c; ropeS[idx] = (float)s; }
        for (int idx = gt; idx < 8 * 512 * 256; idx += NGT) { const int g = idx >> 17, lp = (idx >> 8) & 511, cch = idx & 255, l = lp & 255; const float fr = (float)((l * cch) & 255) * (1.0f / 256.0f);
            csT[idx] = (bf16_t)f2bf((lp < 256 ? __builtin_amdgcn_cosf(fr) : __builtin_amdgcn_sinf(fr)) * gF[g * 256 + cch]); }
        for (int idx = gt; idx < 2 * 8 * 128 * 128; idx += NGT) wspT[idx] = (bf16_t)f2bf(a_w_s[idx]); }
    PH_END(0)

    PH_BEGIN(1)
        pg8::BatchOrder S; S.nM = 9; S.nN = 4; S.nZ = NLAYER; S.G = G; S.c = bx; S.ldc = 1024;
        S.sAm = (size_t)256 * D; S.sAz = (size_t)NMEMTOK * D; S.sBn = (size_t)256 * D; S.sBz = (size_t)1024 * D; S.sCm = (size_t)256 * 1024; S.sCn = 256; S.sCz = (size_t)NMEMTOK * 1024;
        pg8::EpiBf16<0, 0> E{WSP(bf16_t, WS_KV), 1.f, nullptr};
        pg8::gemm_phase(tid, lds, WSP(bf16_t, WS_MEMN), WSP(bf16_t, WS_XWKV), D, D, D / 64, S, E);
    PH_END(1)

    for (int hl = 0; hl < 2 * NLAYER; ++hl) {
        const int layer = hl >> 1, which = hl & 1;
        PH_BEGIN(2)
            pg8::StdOrder S; S.init(NTOK, 2 * DFF, D, D, DFF, G, PG8_XCD_REMAP ? bx : vcu);
            pg8::EpiSwiGLU E{WSP(bf16_t, WS_A), WSP(float, WS_RSTD)};
            PREP(1) pg8::gemm_phase(tid, lds, WSP(bf16_t, WS_H), WSP(bf16_t, WS_W1), D, D, D / 64, S, E);
        PH_END(2)
        PH_BEGIN(3)
            pg8::StdOrder S; S.init(NTOK, D, DFF, DFF, D, G, PG8_XCD_REMAP ? bx : vcu);
            pg8::EpiBf16<0, 0> E{WSP(bf16_t, WS_B), 1.f, nullptr};
            PREP(2) pg8::gemm_phase(tid, lds, WSP(bf16_t, WS_A), WSP(bf16_t, WS_WD), DFF, DFF, DFF / 64, S, E);
        PH_END(3)
        PH_BEGIN(4)
            const float* ln_pre = ap->in[4]; const float* ln_post = ap->in[5];
            const float* gpost = ln_post + (size_t)(layer * 4 + (which ? 3 : 0)) * D;
            if (hl == 2 * NLAYER - 1) rowpass<false, true>(nullptr, nullptr, WSP(bf16_t, WS_H), ap->out, WSP(bf16_t, WS_B), nullptr, gpost, 0.5f, gw, NGW, lane);
            else {
                rowpass<false, false>(nullptr, nullptr, WSP(bf16_t, WS_H), nullptr, WSP(bf16_t, WS_B), WSP(float, WS_RSTD), gpost, 0.5f, gw, NGW, lane);
                const size_t wo = (size_t)(hl + 1) * D * DFF; const int l2 = (hl + 1) >> 1, w2 = (hl + 1) & 1;
                PREP(4) convert_ffn_weights(ap->in[7] + wo, ap->in[8] + wo, ap->in[9] + wo, ln_pre + (size_t)(l2 * 4 + (w2 ? 3 : 0)) * D, WSP(bf16_t, WS_W1), WSP(bf16_t, WS_WD), (LAS float*)(lds + wave * 16384), gw, NGW, lane); }
        PH_END(4)
        if (which == 0) {
            const int kind = layer % 3, slot = layer / 3;
            if (kind == 0) {
                PH_BEGIN(5)
                    pg8::StdOrder S; S.init(NTOK, 4096, D, D, 4096, G, PG8_XCD_REMAP ? bx : vcu);
                    pg8::EpiBf16<1, 1> E{WSP(bf16_t, WS_A), 1.f, WSP(float, WS_RSTD)};
                    PREP(9) pg8::gemm_phase(tid, lds, WSP(bf16_t, WS_H), WSP(bf16_t, WS_AWIN) + (size_t)slot * 4096 * D, D, D, D / 64, S, E);
                PH_END(5)
                PH_BEGIN(6)
                    const bf16_t* RA = WSP(bf16_t, WS_A); f32x2* vstats = WSP(f32x2, WS_STATS);
                    PREP(7) for (int row = gw; row < NTOK; row += NGW) {
                        const GAS u32x4* vr = (const GAS u32x4*)(RA + (size_t)row * 4096 + 2048) + lane; u32x4 v[4]; float s = 0.f;
#pragma unroll
                        for (int j = 0; j < 4; ++j) { v[j] = vr[64 * j]; s += (bf_lo(v[j].x) + bf_hi(v[j].x)) + (bf_lo(v[j].y) + bf_hi(v[j].y)) + (bf_lo(v[j].z) + bf_hi(v[j].z)) + (bf_lo(v[j].w) + bf_hi(v[j].w)); }
                        const float mean = wave_sum(s, lane) * (1.0f / 2048.0f); float q = 0.f;
#pragma unroll
                        for (int j = 0; j < 4; ++j) { const unsigned w4[4] = {v[j].x, v[j].y, v[j].z, v[j].w};
#pragma unroll
                            for (int k = 0; k < 4; ++k) { const float a = bf_lo(w4[k]) - mean, b = bf_hi(w4[k]) - mean; q += a * a + b * b; } }
                        const float rstd = rsqrtf(wave_sum(q, lane) * (1.0f / 2048.0f) + 1e-5f);
                        if (lane == 0) vstats[row] = (f32x2){mean, rstd};
                    }
                PH_END(6)
                PH_BEGIN(7)
                    using namespace att;
                    const bf16_t* RA = WSP(bf16_t, WS_A); bf16_t* MX = WSP(bf16_t, WS_B); const f32x2* vstats = WSP(f32x2, WS_STATS); const bf16_t* wspT = WSP(bf16_t, WS_WSP);
                    const float* a_b_s = ap->in[14];
                    const int r32 = lane & 31, hi2 = lane >> 5, pb = wave & 3, ch = wave >> 2;
                    const int sr = tid >> 4, sc = (tid & 15) * 8, vst0 = v_st(sr, sc), vst1 = v_st(32 + sr, sc);
                    const int vb0 = (int)(uintptr_t)(lds_raw) + v_rd_base(lane);
                    const float* lng = ap->in[11] + (size_t)slot * 2048; const float* lnb = ap->in[12] + (size_t)slot * 2048;
                    PREP(7) for (int un = vcu; un < 320 * 8; un += G) {
                        const int g = un & 7, ck = un >> 3; const int tok0 = ck * 128;
                        __syncthreads();
#pragma unroll
                        for (int hc = 0; hc < 2; ++hc) {
                            const int gc = g * 256 + hc * 128 + sc;
                            const f32x4 g0 = *(const f32x4*)(lng + gc), g1 = *(const f32x4*)(lng + gc + 4), b0 = *(const f32x4*)(lnb + gc), b1 = *(const f32x4*)(lnb + gc + 4);
#pragma unroll
                            for (int kt = 0; kt < 2; ++kt)
#pragma unroll
                                for (int rr = 0; rr < 2; ++rr) { const int q = kt * 64 + rr * 32 + sr; const int tok = tok0 + q;
                                    const u32x4 raw = *(const GAS u32x4*)(RA + (size_t)tok * 4096 + 2048 + gc); const f32x2 st = vstats[tok];
                                    f32x4 a = (f32x4){bf_lo(raw.x), bf_hi(raw.x), bf_lo(raw.y), bf_hi(raw.y)}, b = (f32x4){bf_lo(raw.z), bf_hi(raw.z), bf_lo(raw.w), bf_hi(raw.w)};
                                    a = (a - st.x) * st.y * g0 + b0; b = (b - st.x) * st.y * g1 + b1;
                                    u32x4 w; w.x = cvt_pk_bf16(a.x, a.y); w.y = cvt_pk_bf16(a.z, a.w); w.z = cvt_pk_bf16(b.x, b.y); w.w = cvt_pk_bf16(b.z, b.w);
                                    *(LAS u32x4*)(lds + (kt * 2 + hc) * 16384 + (rr ? vst1 : vst0)) = w; }
                        }
                        bf16x8 pa[2][4];
                        const bf16_t* wrow = wspT + ((size_t)(slot * 8 + g) * 128 + 32 * pb + r32) * 128 + 8 * hi2;
#pragma unroll
                        for (int kt = 0; kt < 2; ++kt)
#pragma unroll
                            for (int i = 0; i < 4; ++i) pa[kt][i] = *(const bf16x8*)(wrow + kt * 64 + 16 * i);
                        __syncthreads();
                        f32x16 o[4] = {};
                        pv_d0(o, vb0 + (0 * 2 + ch) * 16384, pa[0][0], pa[0][1], pa[0][2], pa[0][3]);
                        pv_d0(o, vb0 + (1 * 2 + ch) * 16384, pa[1][0], pa[1][1], pa[1][2], pa[1][3]);
#pragma unroll
                        for (int r = 0; r < 16; ++r) { const int p = 32 * pb + crow(r, hi2); const int tok = tok0 + p; const float bias = a_b_s[(size_t)(slot * 8 + g) * 128 + p];
#pragma unroll
                            for (int d0 = 0; d0 < 4; ++d0) { const int c = g * 256 + ch * 128 + d0 * 32 + r32;
                                const float uu = bf_lo((unsigned)RA[(size_t)tok * 4096 + c]);
                                MX[(size_t)tok * D + c] = (bf16_t)f2bf(uu * (o[d0][r] + bias)); } }
                    }
                    __syncthreads();
                PH_END(7)
            } else if (kind == 1) {
                PH_BEGIN(8)
                    pg8::StdOrder S; S.init(NTOK, 6144, D, D, 6144, G, PG8_XCD_REMAP ? bx : vcu);
                    pg8::EpiBf16<0, 1> E{WSP(bf16_t, WS_A), 1.f, WSP(float, WS_RSTD)};
                    PREP(9) pg8::gemm_phase(tid, lds, WSP(bf16_t, WS_H), WSP(bf16_t, WS_BWQKV), D, D, D / 64, S, E);
                PH_END(8)
                PH_BEGIN(9)
                    bf16_t* RA = WSP(bf16_t, WS_A); const float* ropeC = WSP(float, WS_ROPE_COS); const float* ropeS = WSP(float, WS_ROPE_SIN);
                    const int v = lane >> 1, half = lane & 1;
                    const int colbase = (v < 16 ? v * 128 : 2048 + (v - 16) * 128) + 8 * half;
                    for (int row = gw; row < NTOK; row += NGW) {
                        const int pos = row < NPROMPT ? row : (row & (SSAMP - 1));
                        GAS u32x4* p1 = (GAS u32x4*)(RA + (size_t)row * 6144 + colbase); GAS u32x4* p2 = (GAS u32x4*)(RA + (size_t)row * 6144 + colbase + 16);
                        const u32x4 a = *p1, b = *p2;
                        const f32x4 c0 = *(const f32x4*)(ropeC + pos * 16 + 8 * half), c1 = *(const f32x4*)(ropeC + pos * 16 + 8 * half + 4), s0 = *(const f32x4*)(ropeS + pos * 16 + 8 * half), s1 = *(const f32x4*)(ropeS + pos * 16 + 8 * half + 4);
                        const float x1[8] = {bf_lo(a.x), bf_hi(a.x), bf_lo(a.y), bf_hi(a.y), bf_lo(a.z), bf_hi(a.z), bf_lo(a.w), bf_hi(a.w)};
                        const float x2[8] = {bf_lo(b.x), bf_hi(b.x), bf_lo(b.y), bf_hi(b.y), bf_lo(b.z), bf_hi(b.z), bf_lo(b.w), bf_hi(b.w)};
                        const float cc[8] = {c0.x, c0.y, c0.z, c0.w, c1.x, c1.y, c1.z, c1.w}, sn[8] = {s0.x, s0.y, s0.z, s0.w, s1.x, s1.y, s1.z, s1.w};
                        float o1[8], o2[8];
#pragma unroll
                        for (int j = 0; j < 8; ++j) { o1[j] = x1[j] * cc[j] - x2[j] * sn[j]; o2[j] = x2[j] * cc[j] + x1[j] * sn[j]; }
                        *p1 = (u32x4){cvt_pk_bf16(o1[0], o1[1]), cvt_pk_bf16(o1[2], o1[3]), cvt_pk_bf16(o1[4], o1[5]), cvt_pk_bf16(o1[6], o1[7])};
                        *p2 = (u32x4){cvt_pk_bf16(o2[0], o2[1]), cvt_pk_bf16(o2[2], o2[3]), cvt_pk_bf16(o2[4], o2[5]), cvt_pk_bf16(o2[6], o2[7])};
                    }
                PH_END(9)
                PH_BEGIN(10)
                    const bf16_t* RA = WSP(bf16_t, WS_A); bf16_t* RB = WSP(bf16_t, WS_B);
                    PREP(5) for (int idx = vcu; idx < 2560; idx += G) {
                        int h16, qb, seq; size_t t0;
                        if (idx < 512) { const int i = idx >> 8, w = idx & 255; h16 = (w >> 5) * 2 + i; qb = w & 31; t0 = 0; seq = NPROMPT; }
                        else { const int id2 = idx - 512, r = id2 >> 8, w = id2 & 255; const int b = w >> 5, jj = w & 31; h16 = 2 * r + (jj >> 4); qb = jj & 15; t0 = (size_t)NPROMPT + (size_t)b * SSAMP; seq = SSAMP; }
                        const bf16_t* Q = RA + (t0 + qb * 256) * 6144 + h16 * 128; const bf16_t* K = RA + t0 * 6144 + 2048 + h16 * 128; const bf16_t* V = RA + t0 * 6144 + 4096 + (h16 >> 1) * 256;
                        bf16_t* O = RB + (size_t)(h16 & 1) * NTOK * D + (t0 + qb * 256) * D + (h16 >> 1) * 256;
                        const int tid2 = wave * 64 + lane_id_asm();
                        att2::attn256_body<6144, 6144, 2048>(tid2, Q, K, V, O, seq, lds); }
                    __syncthreads();
                PH_END(10)
                PH_BEGIN(11)
                    const float* b_lq1 = ap->in[17]; const float* b_lk1 = ap->in[18]; const float* b_lq2 = ap->in[19]; const float* b_lk2 = ap->in[20]; const float* b_subln = ap->in[21];
                    const float lam_init = 0.8f - 0.6f * expf(-0.3f * (float)layer);
                    float d1 = b_lq1[lane] * b_lk1[lane] + b_lq1[lane + 64] * b_lk1[lane + 64], d2 = b_lq2[lane] * b_lk2[lane] + b_lq2[lane + 64] * b_lk2[lane + 64];
                    const float lam = expf(wave_sum(d1, lane)) - expf(wave_sum(d2, lane)) + lam_init;
                    const f32x4 sg = *(const f32x4*)(b_subln + 4 * lane); const float osc = 1.0f - lam_init;
                    const bf16_t* O0 = WSP(bf16_t, WS_B); const bf16_t* O1 = O0 + (size_t)NTOK * D; bf16_t* CO = WSP(bf16_t, WS_A);
                    for (int row = gw; row < NTOK; row += NGW) {
                        const GAS u32x2* p0 = (const GAS u32x2*)(O0 + (size_t)row * D) + lane; const GAS u32x2* p1 = (const GAS u32x2*)(O1 + (size_t)row * D) + lane;
                        GAS u32x2* po = (GAS u32x2*)(CO + (size_t)row * D) + lane;
                        u32x2 a[8], b[8];
#pragma unroll
                        for (int j = 0; j < 8; ++j) { a[j] = p0[64 * j]; b[j] = p1[64 * j]; }
#pragma unroll
                        for (int j = 0; j < 8; ++j) { f32x4 dv = (f32x4){bf_lo(a[j].x) - lam * bf_lo(b[j].x), bf_hi(a[j].x) - lam * bf_hi(b[j].x), bf_lo(a[j].y) - lam * bf_lo(b[j].y), bf_hi(a[j].y) - lam * bf_hi(b[j].y)};
                            const float ss = wave_sum((dv.x * dv.x + dv.y * dv.y) + (dv.z * dv.z + dv.w * dv.w), lane); const float r = rsqrtf(ss * (1.0f / 256.0f) + 1e-5f) * osc;
                            dv = dv * r * sg; u32x2 w; w.x = cvt_pk_bf16(dv.x, dv.y); w.y = cvt_pk_bf16(dv.z, dv.w); po[64 * j] = w; }
                    }
                PH_END(11)
            } else {
                PH_BEGIN(12)
                    {
                        bf16_t* Tp = WSP(bf16_t, WS_B); bf16_t* Ts = Tp + (size_t)8192 * 16384;
                        const long gt = (long)vcu * NTHREADS + tid, NGT = (long)G * NTHREADS;
                        for (long it = gt; it < (long)8192 * 2048; it += NGT) { const int k = (int)(it >> 11), c8 = (int)(it & 2047), part = c8 >> 10, s0 = (c8 & 1023) * 8; unsigned w[4];
#pragma unroll
                            for (int e = 0; e < 4; ++e) { const float f0 = (float)((k * (s0 + 2 * e)) & 8191) * (1.0f / 8192.0f), f1 = (float)((k * (s0 + 2 * e + 1)) & 8191) * (1.0f / 8192.0f);
                                const float v0 = part ? -__builtin_amdgcn_sinf(f0) : __builtin_amdgcn_cosf(f0), v1 = part ? -__builtin_amdgcn_sinf(f1) : __builtin_amdgcn_cosf(f1); w[e] = cvt_pk_bf16(v0, v1); }
                            *(GAS u32x4*)(Tp + (size_t)k * 16384 + part * 8192 + s0) = (u32x4){w[0], w[1], w[2], w[3]}; }
                        for (long it = gt; it < (long)4096 * 1024; it += NGT) { const int k = (int)(it >> 10), c8 = (int)(it & 1023), part = c8 >> 9, s0 = (c8 & 511) * 8; unsigned w[4];
#pragma unroll
                            for (int e = 0; e < 4; ++e) { const float f0 = (float)((k * (s0 + 2 * e)) & 4095) * (1.0f / 4096.0f), f1 = (float)((k * (s0 + 2 * e + 1)) & 4095) * (1.0f / 4096.0f);
                                const float v0 = part ? -__builtin_amdgcn_sinf(f0) : __builtin_amdgcn_cosf(f0), v1 = part ? -__builtin_amdgcn_sinf(f1) : __builtin_amdgcn_cosf(f1); w[e] = cvt_pk_bf16(v0, v1); }
                            *(GAS u32x4*)(Ts + (size_t)k * 8192 + part * 4096 + s0) = (u32x4){w[0], w[1], w[2], w[3]}; }
                    }
                    pg8::F1Order S; S.G = G; S.c = bx;
                    pg8::EpiBf16<0, 2> E{WSP(bf16_t, WS_A), 1.f, WSP(float, WS_RSTD)};
                    int nt4 = 4; asm volatile("" : "+s"(nt4));
                    pg8::gemm_phase(tid, lds, WSP(bf16_t, WS_CS), WSP(bf16_t, WS_H), 256, D, nt4, S, E);
                PH_END(12)
                PH_BEGIN(13)
                    bf16_t* Y = WSP(bf16_t, WS_A + 320 * MiB);
                    {   pg8::StdOrder S; S.init(NPROMPT, D, 16384, 16384, D, G, PG8_XCD_REMAP ? bx : vcu);
                        pg8::EpiBf16<0, 0> E{Y, 6.9053396600248786e-04f, nullptr};
                        pg8::gemm_phase(tid, lds, WSP(bf16_t, WS_B), WSP(bf16_t, WS_A), 16384, 16384, 256, S, E); }
                    {   pg8::BatchOrder S; S.nM = 16; S.nN = 8; S.nZ = 8; S.G = G; S.c = bx; S.ldc = D;
                        S.sAm = (size_t)256 * 8192; S.sAz = 0; S.sBn = (size_t)256 * 8192; S.sBz = (size_t)2048 * 8192; S.sCm = (size_t)256 * D; S.sCn = 256; S.sCz = (size_t)SSAMP * D;
                        pg8::EpiBf16<0, 0> E{Y + (size_t)NPROMPT * D, 9.765625e-04f, nullptr};
                        pg8::gemm_phase(tid, lds, WSP(bf16_t, WS_B) + (size_t)8192 * 16384, WSP(bf16_t, WS_A) + (size_t)2048 * 16384, 8192, 8192, 128, S, E); }
                PH_END(13)
            }
            PH_BEGIN(14)
                const bf16_t* WOT = kind == 0 ? WSP(bf16_t, WS_AWOUT) + (size_t)slot * D * D : (kind == 1 ? WSP(bf16_t, WS_BWOUT) : WSP(bf16_t, WS_CWOUT));
                const bf16_t* MXI = kind == 0 ? WSP(bf16_t, WS_B) : (kind == 1 ? WSP(bf16_t, WS_A) : WSP(bf16_t, WS_A + 320 * MiB));
                pg8::StdOrder S; S.init(NTOK, D, D, D, D, G, PG8_XCD_REMAP ? bx : vcu);
                pg8::EpiBf16<0, 0> E{kind == 1 ? WSP(bf16_t, WS_B) : WSP(bf16_t, WS_A), 1.f, nullptr};
                PREP(9) pg8::gemm_phase(tid, lds, MXI, WOT, D, D, D / 64, S, E);
            PH_END(14)
            PH_BEGIN(15)
                rowpass<false, false>(nullptr, nullptr, WSP(bf16_t, WS_H), nullptr, kind == 1 ? WSP(bf16_t, WS_B) : WSP(bf16_t, WS_A), WSP(float, WS_RSTD), ap->in[5] + (size_t)(layer * 4 + 1) * D, 1.0f, gw, NGW, lane);
            PH_END(15)
            PH_BEGIN(16)
                pg8::StdOrder S; S.init(NTOK, 512, D, D, 512, G, PG8_XCD_REMAP ? bx : vcu);
                pg8::EpiBf16<0, 1> E{WSP(bf16_t, WS_A), 1.f, WSP(float, WS_RSTD)};
                PREP(9) pg8::gemm_phase(tid, lds, WSP(bf16_t, WS_H), WSP(bf16_t, WS_XWQ) + (size_t)layer * 512 * D, D, D, D / 64, S, E);
            PH_END(16)
            PH_BEGIN(17)
                const bf16_t* QX = WSP(bf16_t, WS_A); bf16_t* OX = WSP(bf16_t, WS_A) + (size_t)NTOK * 512;
                const bf16_t* KVl = WSP(bf16_t, WS_KV) + (size_t)layer * NMEMTOK * 1024;
                PREP(8) for (int idx = vcu; idx < 640; idx += G) { const int tb = idx >> 2, head = idx & 3; const int bm = tb < 32 ? 0 : 1 + ((tb - 32) >> 4);
                    const bf16_t* Q = QX + (size_t)tb * 256 * 512 + head * 128; const bf16_t* K = KVl + (size_t)bm * 256 * 1024 + head * 128; const bf16_t* V = K + 512;
                    bf16_t* O = OX + (size_t)tb * 256 * 512 + head * 128;
                    const int tid2 = wave * 64 + lane_id_asm();
                    att::attn_dense_body<512, 1024, 512>(tid2, Q, K, V, O, 256, 0, (char*)lds_raw); __syncthreads(); }
            PH_END(17)
            PH_BEGIN(18)
                pg8::StdOrder S; S.init(NTOK, D, 512, 512, D, G, PG8_XCD_REMAP ? bx : vcu);
                pg8::EpiBf16<0, 0> E{WSP(bf16_t, WS_A) + (size_t)NTOK * 1024, 1.f, nullptr};
                PREP(9) pg8::gemm_phase(tid, lds, WSP(bf16_t, WS_A) + (size_t)NTOK * 512, WSP(bf16_t, WS_XWOUT) + (size_t)layer * D * 512, 512, 512, 8, S, E);
            PH_END(18)
            PH_BEGIN(19)
                rowpass<false, false>(nullptr, nullptr, WSP(bf16_t, WS_H), nullptr, WSP(bf16_t, WS_A) + (size_t)NTOK * 1024, WSP(float, WS_RSTD), ap->in[5] + (size_t)(layer * 4 + 2) * D, 1.0f, gw, NGW, lane);
            PH_END(19)
        }
    }
    if (PROBE_T && bx == 0) { const unsigned long long t0_ = __builtin_amdgcn_s_memrealtime(); while (__builtin_amdgcn_s_memrealtime() - t0_ < PROBE_AMP * pr_acc) __builtin_amdgcn_s_sleep(8); }
#undef PH_BEGIN
#undef PH_END
#undef WSP
}

extern "C" void kernel_launch(void* const* d_in, const int* in_sizes, int n_in, void* d_out, int out_size, void* d_ws, size_t ws_size, hipStream_t stream) {
    static int grid = 0;
    if (grid == 0) {
        if (n_in != 27 || out_size != NTOK * D || ws_size < WS_END) { fprintf(stderr, "kernel_launch: unexpected shapes: n_in %d out %d ws %zu (need %zu)\n", n_in, out_size, ws_size, (size_t)WS_END); grid = -1; return; }
        int dev = 0, cus = 0, per_cu = 0;
        if (hipGetDevice(&dev) != hipSuccess || hipDeviceGetAttribute(&cus, hipDeviceAttributeMultiprocessorCount, dev) != hipSuccess) { grid = -1; return; }
        if (hipFuncSetAttribute((const void*)trunk_fwd, hipFuncAttributeMaxDynamicSharedMemorySize, LDS_BYTES) != hipSuccess) { fprintf(stderr, "kernel_launch: hipFuncSetAttribute failed\n"); grid = -1; return; }
        if (hipOccupancyMaxActiveBlocksPerMultiprocessor(&per_cu, (const void*)trunk_fwd, NTHREADS, LDS_BYTES) != hipSuccess || per_cu < 1) fprintf(stderr, "kernel_launch: occupancy query reports %d\n", per_cu);
        (void)hipGetLastError();
        grid = cus;
    }
    if (grid < 0) return;
    (void)hipMemsetAsync((char*)d_ws + WS_CTL, 0, CTL_ZERO_BYTES, stream);
    Args a{};
    for (int i = 0; i < 27; ++i) a.in[i] = (const float*)d_in[i];
    a.out = (float*)d_out; a.ws = (unsigned char*)d_ws;
    constexpr int NPH = total_phases();
#if MK_PER_PHASE
    for (int p = 0; p < NPH; ++p) { a.ph_lo = p; a.ph_hi = p + 1; hipLaunchKernelGGL(trunk_fwd, dim3(grid), dim3(NTHREADS), LDS_BYTES, stream, a); }
#else
    a.ph_lo = 0; a.ph_hi = NPH; hipLaunchKernelGGL(trunk_fwd, dim3(grid), dim3(NTHREADS), LDS_BYTES, stream, a);
#endif
    const hipError_t le = hipPeekAtLastError();
    if (le != hipSuccess) fprintf(stderr, "kernel_launch: launch failed: %s\n", hipGetErrorName(le));
}
```
